# Optimizing an MI355X kernel written in HIP

```python
import math
import jax
import jax.numpy as jnp
from jax import lax
import numpy as np

D_MODEL = 1024
BATCH = 8
SEQ = 8192
DEPTH = 4

N_MIXERS = 4
N_MEM = 256
EPS = 1e-6
ROPE_THETA = 10000.0
POS_OFFSET_MAX = 4096
CHUNK = 64
D_MIX = 768
XA_HEADS = 4
XA_HEAD_DIM = 64
D_XA = XA_HEADS * XA_HEAD_DIM
GLA_HEADS = 4
GLA_DK = D_MIX // 2 // GLA_HEADS
GLA_DV = D_MIX // GLA_HEADS
GLA_RANK = 16
GLA_GATE_NORM = 16.0
DIL_GROUPS = ((128, 1), (512, 4), (2048, 16))
DIL_HEADS = 4
DIL_HEAD_DIM = 128
DIL_BLOCK = 128
D_DIL = DIL_HEADS * DIL_HEAD_DIM
SSM_HEAD_DIM = 64
SSM_HEADS = D_MIX // SSM_HEAD_DIM
SSM_GROUPS = 2
SSM_STATE = 128
SSM_CONV = 4
HGRN_EXPAND = 128
HGRN_HEADS = D_MIX // HGRN_EXPAND
HGRN_DK = HGRN_EXPAND
HGRN_DV = D_MIX // HGRN_HEADS
D_FF = 2816
FFN_CONV = 3

kernel_name = "hybrid_interleaved_gla_dilated_ssd_hgrn2_block"

F32 = jnp.float32


def rms_norm(x, g):
    xf = x.astype(F32)
    y = xf * lax.rsqrt(jnp.mean(xf * xf, axis=-1, keepdims=True) + EPS)
    return (y * g.astype(F32)).astype(x.dtype)


def split_cols(y, sizes):
    return jnp.split(y, [int(c) for c in np.cumsum(sizes)[:-1]], axis=-1)


def causal_dwconv(x, w, b):
    K, S = w.shape[0], x.shape[1]
    xp = jnp.pad(x, ((0, 0), (K - 1, 0), (0, 0)))
    y = b
    for j in range(K):
        y = y + xp[:, j:j + S] * w[j]
    return y


def rope_tables(positions, dim):
    half = dim // 2
    inv_freq = ROPE_THETA ** (-jnp.arange(half, dtype=F32) / half)
    ang = positions.astype(F32)[..., None] * inv_freq
    return jnp.cos(ang)[:, :, None], jnp.sin(ang)[:, :, None]


def apply_rope(x, cos, sin):
    half = x.shape[-1] // 2
    x1, x2 = x[..., :half].astype(F32), x[..., half:].astype(F32)
    return jnp.concatenate([x1 * cos - x2 * sin, x2 * cos + x1 * sin], axis=-1).astype(x.dtype)


def chunked_gla(q, k, v, log_a):
    Bsz, S, H, K = q.shape
    V = v.shape[-1]
    C = CHUNK
    n = S // C
    q, k, v, log_a = (t.astype(F32).reshape(Bsz, n, C, H, -1) for t in (q, k, v, log_a))
    b = jnp.cumsum(log_a, axis=2)
    b_last = b[:, :, -1:]
    b_ref = b[:, :, C // 2 - 1:C // 2]
    att = jnp.einsum('bnihk,bnjhk->bnhij', q * jnp.exp(b - b_ref), k * jnp.exp(b_ref - b))
    att = jnp.where(jnp.tril(jnp.ones((C, C), bool)), att, 0.0)
    o_intra = jnp.einsum('bnhij,bnjhv->bnihv', att, v)
    q_inter = q * jnp.exp(b)
    k_state = k * jnp.exp(b_last - b)
    decay = jnp.exp(b_last[:, :, 0])

    def step(state, xs):
        qc, kc, vc, dc = xs
        o = jnp.einsum('bchk,bhkv->bchv', qc, state)
        state = dc[..., None] * state + jnp.einsum('bchk,bchv->bhkv', kc, vc)
        return state, o

    tm = lambda t: jnp.moveaxis(t, 1, 0)
    _, o_inter = lax.scan(step, jnp.zeros((Bsz, H, K, V), F32),
                          (tm(q_inter), tm(k_state), tm(v), tm(decay)))
    return (o_intra + jnp.moveaxis(o_inter, 0, 1)).reshape(Bsz, S, H, V)


def ssd_chunked(x, dt, A, Bm, Cm):
    Bsz, S, G, Hg, P = x.shape
    N = Bm.shape[-1]
    C = CHUNK
    n = S // C
    a = (dt * A).reshape(Bsz, n, C, G, Hg)
    xdt = (x * dt[..., None]).reshape(Bsz, n, C, G, Hg, P)
    Bc = Bm.astype(F32).reshape(Bsz, n, C, G, N)
    Cc = Cm.astype(F32).reshape(Bsz, n, C, G, N)
    acs = jnp.cumsum(a, axis=2)
    seg = acs[:, :, :, None] - acs[:, :, None]
    causal = jnp.tril(jnp.ones((C, C), bool))[:, :, None, None]
    Lmat = jnp.exp(jnp.where(causal, seg, -jnp.inf))
    cb = jnp.einsum('bnlgk,bnsgk->bnlsg', Cc, Bc)
    y_diag = jnp.einsum('bnlsgh,bnsghp->bnlghp', cb[..., None] * Lmat, xdt)
    x_end = xdt * jnp.exp(acs[:, :, -1:] - acs)[..., None]
    in_decay = jnp.exp(acs)
    chunk_decay = jnp.exp(acs[:, :, -1])

    def step(hst, xs):
        c_c, b_c, xe_c, ind_c, cd_c = xs
        y_off = jnp.einsum('blgk,bghpk->blghp', c_c, hst) * ind_c[..., None]
        hst = cd_c[..., None, None] * hst + jnp.einsum('bsgk,bsghp->bghpk', b_c, xe_c)
        return hst, y_off

    tm = lambda t: jnp.moveaxis(t, 1, 0)
    _, y_off = lax.scan(step, jnp.zeros((Bsz, G, Hg, P, N), F32),
                        (tm(Cc), tm(Bc), tm(x_end), tm(in_decay), tm(chunk_decay)))
    return (y_diag + jnp.moveaxis(y_off, 0, 1)).reshape(Bsz, S, G, Hg, P)


def dilated_window_attention(q, k, v, window, dilation):
    Bsz, S, H, hd = q.shape
    r = dilation
    W = window // dilation
    Q = DIL_BLOCK
    L = S // r
    nb = -(-L // Q)
    Lp = nb * Q

    def to_blocks(t):
        t = t.reshape(Bsz, L, r, H, hd).transpose(0, 2, 1, 3, 4)
        t = jnp.pad(t, ((0, 0), (0, 0), (0, Lp - L), (0, 0), (0, 0)))
        return t.reshape(Bsz, r, nb, Q, H, hd)

    def with_prev(t):
        prev = jnp.pad(t, ((0, 0), (0, 0), (1, 0), (0, 0), (0, 0), (0, 0)))[:, :, :-1]
        return jnp.concatenate([prev, t], axis=3)

    qb = to_blocks(q)
    kk = with_prev(to_blocks(k))
    vv = with_prev(to_blocks(v))
    i = jnp.arange(Q)[:, None]
    j = jnp.arange(2 * Q)[None, :]
    dist = Q + i - j
    band = (dist >= 0) & (dist <= W)
    valid = (jnp.arange(nb)[:, None, None] > 0) | (j >= Q)[None]
    mask = band[None] & valid
    s = jnp.einsum('brnqhd,brnkhd->brnhqk', qb, kk).astype(F32) * (hd ** -0.5)
    s = jnp.where(mask[None, None, :, None], s, -jnp.inf)
    m = jnp.max(s, axis=-1, keepdims=True)
    p = jnp.exp(s - m)
    l = jnp.sum(p, axis=-1, keepdims=True)
    o = jnp.einsum('brnhqk,brnkhd->brnqhd', p / l, vv.astype(F32))
    lse = (m + jnp.log(l))[..., 0].transpose(0, 1, 2, 4, 3)
    o = o.reshape(Bsz, r, Lp, H, hd)[:, :, :L].transpose(0, 2, 1, 3, 4).reshape(Bsz, S, H, hd)
    lse = lse.reshape(Bsz, r, Lp, H)[:, :, :L].transpose(0, 2, 1, 3).reshape(Bsz, S, H)
    return o, lse


def gla_mixer(h, w_in, w_gate2, b_gate, o_norm):
    Bsz, S, _ = h.shape
    q, k, v, glr, og, xq = split_cols(
        h @ w_in, [GLA_HEADS * GLA_DK, GLA_HEADS * GLA_DK, D_MIX, GLA_RANK, D_MIX, D_XA])
    log_a = jax.nn.log_sigmoid((glr @ w_gate2 + b_gate).astype(F32)) / GLA_GATE_NORM
    hs = lambda t: t.reshape(Bsz, S, GLA_HEADS, -1)
    o = chunked_gla(hs(q) * (GLA_DK ** -0.5), hs(k), hs(v), hs(log_a))
    o = rms_norm(o, o_norm).reshape(Bsz, S, D_MIX) * jax.nn.silu(og.astype(F32))
    return o.astype(h.dtype), xq


def dilated_mixer(h, w_in, q_norm, k_norm, positions):
    Bsz, S, _ = h.shape
    nh = len(DIL_GROUPS) * DIL_HEADS
    q, k, v, xq = split_cols(h @ w_in, [nh * DIL_HEAD_DIM] * 3 + [D_XA])
    hs = lambda t: t.reshape(Bsz, S, nh, DIL_HEAD_DIM)
    cos, sin = rope_tables(positions, DIL_HEAD_DIM)
    q = apply_rope(rms_norm(hs(q), q_norm), cos, sin)
    k = apply_rope(rms_norm(hs(k), k_norm), cos, sin)
    v = hs(v)
    outs, lses = [], []
    for g, (window, dilation) in enumerate(DIL_GROUPS):
        sl = slice(g * DIL_HEADS, (g + 1) * DIL_HEADS)
        o, lse = dilated_window_attention(q[:, :, sl], k[:, :, sl], v[:, :, sl], window, dilation)
        outs.append(o)
        lses.append(lse)
    wts = jax.nn.softmax(jnp.stack(lses), axis=0)
    o = jnp.sum(wts[..., None] * jnp.stack(outs), axis=0)
    return o.reshape(Bsz, S, D_DIL).astype(h.dtype), xq


def mamba2_mixer(h, w_in, conv_w, conv_b, dt_bias, a_log, d_skip, norm_g):
    Bsz, S, _ = h.shape
    GN = SSM_GROUPS * SSM_STATE
    hg = SSM_HEADS // SSM_GROUPS
    z, xbc, dt, xq = split_cols(h @ w_in, [D_MIX, D_MIX + 2 * GN, SSM_HEADS, D_XA])
    xbc = jax.nn.silu(causal_dwconv(xbc, conv_w, conv_b))
    xs, bm, cm = split_cols(xbc, [D_MIX, GN, GN])
    dt = jax.nn.softplus(dt.astype(F32) + dt_bias.astype(F32)).reshape(Bsz, S, SSM_GROUPS, hg)
    A = -jnp.exp(a_log.astype(F32)).reshape(SSM_GROUPS, hg)
    xs = xs.astype(F32).reshape(Bsz, S, SSM_GROUPS, hg, SSM_HEAD_DIM)
    y = ssd_chunked(xs, dt, A, bm.reshape(Bsz, S, SSM_GROUPS, SSM_STATE),
                    cm.reshape(Bsz, S, SSM_GROUPS, SSM_STATE))
    y = y + d_skip.astype(F32).reshape(SSM_GROUPS, hg)[..., None] * xs
    y = y.reshape(Bsz, S, D_MIX) * jax.nn.silu(z.astype(F32))
    y = rms_norm(y.reshape(Bsz, S, SSM_GROUPS, -1), norm_g.reshape(SSM_GROUPS, -1))
    return y.reshape(Bsz, S, D_MIX).astype(h.dtype), xq


def hgrn2_mixer(h, w_in, lower_bounds, o_norm, layer):
    Bsz, S, _ = h.shape
    q, f, i, og, xq = split_cols(
        h @ w_in, [HGRN_HEADS * HGRN_DK, HGRN_HEADS * HGRN_DK, D_MIX, D_MIX, D_XA])
    lbs = jnp.cumsum(jax.nn.softmax(lower_bounds.astype(F32), axis=0), axis=0)
    lb = lbs[layer] - lbs[0]
    fg = lb + (1.0 - lb) * jax.nn.sigmoid(f.astype(F32))
    hk = lambda t: t.reshape(Bsz, S, HGRN_HEADS, HGRN_DK)
    o = chunked_gla(hk(jax.nn.silu(q.astype(F32))), hk(1.0 - fg),
                    i.reshape(Bsz, S, HGRN_HEADS, HGRN_DV), hk(jnp.log(fg)))
    o = rms_norm(o, o_norm).reshape(Bsz, S, D_MIX) * jax.nn.sigmoid(og.astype(F32))
    return o.astype(h.dtype), xq


def memory_cross_attention(xq, mem_n, w_kv, q_norm, k_norm):
    Bsz, S, _ = xq.shape
    M = mem_n.shape[1]
    k, v = jnp.split(mem_n @ w_kv, 2, axis=-1)
    q = rms_norm(xq.reshape(Bsz, S, XA_HEADS, XA_HEAD_DIM), q_norm).astype(F32)
    k = rms_norm(k.reshape(Bsz, M, XA_HEADS, XA_HEAD_DIM), k_norm).astype(F32)
    v = v.reshape(Bsz, M, XA_HEADS, XA_HEAD_DIM).astype(F32)
    p = jax.nn.softmax(jnp.einsum('bshd,bmhd->bhsm', q, k) * (XA_HEAD_DIM ** -0.5), axis=-1)
    o = jnp.einsum('bhsm,bmhd->bshd', p, v)
    return o.reshape(Bsz, S, D_XA).astype(xq.dtype)


def conv_ffn(h, w_up, conv_w, conv_b, w_down):
    u = causal_dwconv(h @ w_up, conv_w, conv_b)
    gate, val = jnp.split(u, 2, axis=-1)
    return (jax.nn.silu(gate) * val) @ w_down


def setup_inputs(seed: int = 0) -> dict:
    key = jax.random.key(seed)
    ks = iter(jax.random.split(key, 40))

    def nrm(shape, scale=1.0):
        return jax.random.normal(next(ks), shape, F32) * scale

    def gain(shape):
        return 1.0 + nrm(shape, 0.02)

    D, F = D_MODEL, D_FF
    GN = SSM_GROUPS * SSM_STATE
    a_cols = 2 * GLA_HEADS * GLA_DK + 2 * D_MIX + GLA_RANK + D_XA
    b_cols = 3 * len(DIL_GROUPS) * D_DIL + D_XA
    c_cols = 2 * D_MIX + 2 * GN + SSM_HEADS + D_XA
    d_cols = 2 * HGRN_HEADS * HGRN_DK + 2 * D_MIX + D_XA
    a_out_in, b_out_in = D_MIX + D_XA, D_DIL + D_XA
    c_out_in, d_out_in = D_MIX + D_XA, D_MIX + D_XA
    inp = {}
    inp['x'] = nrm((BATCH, SEQ, D))
    inp['mem'] = nrm((BATCH, N_MEM, D))
    inp['positions'] = (jnp.arange(SEQ, dtype=jnp.int32)[None, :]
                        + jax.random.randint(next(ks), (BATCH, 1), 0, POS_OFFSET_MAX, dtype=jnp.int32))
    inp['mem_norm'] = gain((D,))
    inp['mix_norm'] = gain((DEPTH, D))
    inp['xa_w_kv'] = nrm((DEPTH, D, 2 * D_XA), D ** -0.5)
    inp['xa_q_norm'] = gain((DEPTH, XA_HEAD_DIM))
    inp['xa_k_norm'] = gain((DEPTH, XA_HEAD_DIM))
    inp['ffn_norm'] = gain((DEPTH, D))
    inp['ffn_w_up'] = nrm((DEPTH, D, 2 * F), D ** -0.5)
    inp['ffn_conv_w'] = nrm((DEPTH, FFN_CONV, 2 * F), FFN_CONV ** -0.5)
    inp['ffn_conv_b'] = nrm((DEPTH, 2 * F), 0.02)
    inp['ffn_w_down'] = nrm((DEPTH, F, D), 0.5 * F ** -0.5)
    inp['a_w_in'] = nrm((D, a_cols), D ** -0.5)
    inp['a_w_gate2'] = nrm((GLA_RANK, GLA_HEADS * GLA_DK), GLA_RANK ** -0.5)
    inp['a_b_gate'] = nrm((GLA_HEADS * GLA_DK,), 0.1)
    inp['a_o_norm'] = gain((GLA_DV,))
    inp['a_w_out'] = nrm((a_out_in, D), 0.5 * a_out_in ** -0.5)
    inp['b_w_in'] = nrm((D, b_cols), D ** -0.5)
    inp['b_q_norm'] = gain((DIL_HEAD_DIM,))
    inp['b_k_norm'] = gain((DIL_HEAD_DIM,))
    inp['b_w_out'] = nrm((b_out_in, D), 0.5 * b_out_in ** -0.5)
    inp['c_w_in'] = nrm((D, c_cols), D ** -0.5)
    inp['c_conv_w'] = nrm((SSM_CONV, D_MIX + 2 * GN), 0.5)
    inp['c_conv_b'] = nrm((D_MIX + 2 * GN,), 0.02)
    dt0 = jnp.exp(jax.random.uniform(next(ks), (SSM_HEADS,), F32, math.log(1e-3), math.log(1e-1)))
    inp['c_dt_bias'] = dt0 + jnp.log(-jnp.expm1(-dt0))
    inp['c_a_log'] = jnp.log(jax.random.uniform(next(ks), (SSM_HEADS,), F32, 1.0, 16.0))
    inp['c_d'] = gain((SSM_HEADS,))
    inp['c_norm'] = gain((D_MIX,))
    inp['c_w_out'] = nrm((c_out_in, D), 0.5 * c_out_in ** -0.5)
    inp['d_w_in'] = nrm((D, d_cols), D ** -0.5)
    inp['d_lower_bounds'] = nrm((DEPTH, HGRN_HEADS * HGRN_DK), 0.02)
    inp['d_o_norm'] = gain((HGRN_DV,))
    inp['d_w_out'] = nrm((d_out_in, D), 0.5 * d_out_in ** -0.5)
    return inp


def reference(x, mem, positions, mem_norm, mix_norm, xa_w_kv, xa_q_norm, xa_k_norm,
              ffn_norm, ffn_w_up, ffn_conv_w, ffn_conv_b, ffn_w_down,
              a_w_in, a_w_gate2, a_b_gate, a_o_norm, a_w_out,
              b_w_in, b_q_norm, b_k_norm, b_w_out,
              c_w_in, c_conv_w, c_conv_b, c_dt_bias, c_a_log, c_d, c_norm, c_w_out,
              d_w_in, d_lower_bounds, d_o_norm, d_w_out):
    mem_n = rms_norm(mem, mem_norm)
    for i in range(DEPTH):
        h = rms_norm(x, mix_norm[i])
        kind = i % N_MIXERS
        if kind == 0:
            tok, xq = gla_mixer(h, a_w_in, a_w_gate2, a_b_gate, a_o_norm)
            w_out = a_w_out
        elif kind == 1:
            tok, xq = dilated_mixer(h, b_w_in, b_q_norm, b_k_norm, positions)
            w_out = b_w_out
        elif kind == 2:
            tok, xq = mamba2_mixer(h, c_w_in, c_conv_w, c_conv_b, c_dt_bias, c_a_log, c_d, c_norm)
            w_out = c_w_out
        else:
            tok, xq = hgrn2_mixer(h, d_w_in, d_lower_bounds, d_o_norm, i)
            w_out = d_w_out
        xa = memory_cross_attention(xq, mem_n, xa_w_kv[i], xa_q_norm[i], xa_k_norm[i])
        x = x + jnp.concatenate([tok, xa], axis=-1) @ w_out
        x = x + conv_ffn(rms_norm(x, ffn_norm[i]), ffn_w_up[i], ffn_conv_w[i], ffn_conv_b[i],
                         ffn_w_down[i])
    return x
```

```cpp
#include <hip/hip_runtime.h>
#define DUP_XA 1
#define DUP_P 1
#define DUP_PRE 1
#define DUP_DIL 1

#include <hip/hip_cooperative_groups.h>
#include <cstdio>
namespace cg = cooperative_groups;

#define DI __device__ __forceinline__
#define LAS __attribute__((address_space(3)))
typedef unsigned short bf16_t;
typedef short bf16x8 __attribute__((ext_vector_type(8)));
typedef short s16x4 __attribute__((ext_vector_type(4)));
typedef float f32x4 __attribute__((ext_vector_type(4)));
typedef unsigned u32x4 __attribute__((ext_vector_type(4)));
typedef unsigned u32x2 __attribute__((ext_vector_type(2)));

constexpr int NTOK = 65536, SEQ = 8192, DM = 1024, DFF = 2816;
constexpr int LDS_BYTES = 163840;
constexpr float EPS = 1e-6f;

constexpr size_t al256(size_t x) { return (x + 255) & ~(size_t)255; }
constexpr int NPAD0 = 2816, NPAD1 = 4864, NPAD2 = 2560, NPAD3 = 3328;
constexpr size_t O_WIN0 = 0;
constexpr size_t O_WIN1 = O_WIN0 + (size_t)NPAD0 * 1024 * 2;
constexpr size_t O_WIN2 = O_WIN1 + (size_t)NPAD1 * 1024 * 2;
constexpr size_t O_WIN3 = O_WIN2 + (size_t)NPAD2 * 1024 * 2;
constexpr size_t O_WOUT0 = O_WIN3 + (size_t)NPAD3 * 1024 * 2;
constexpr size_t O_WOUT1 = O_WOUT0 + (size_t)1024 * 1024 * 2;
constexpr size_t O_WOUT2 = O_WOUT1 + (size_t)1024 * 768 * 2;
constexpr size_t O_WOUT3 = O_WOUT2 + (size_t)1024 * 1024 * 2;
constexpr size_t O_WUP = O_WOUT3 + (size_t)1024 * 1024 * 2;
constexpr size_t O_WDN = O_WUP + (size_t)4 * 5632 * 1024 * 2;
constexpr size_t O_WKV = O_WDN + (size_t)4 * 1024 * 2816 * 2;
constexpr size_t O_XB = O_WKV + (size_t)2048 * 1024 * 2;
constexpr size_t O_MEMN = O_XB + (size_t)NTOK * 1024 * 2;
constexpr size_t O_KVM = O_MEMN + (size_t)2048 * 1024 * 2;
constexpr size_t O_SS = O_KVM + (size_t)2048 * 2048 * 2;
constexpr size_t O_LSE = O_SS + (size_t)3 * NTOK * 16 * 4;
constexpr size_t O_ROPE = O_LSE + (size_t)3 * NTOK * 4 * 4;
constexpr size_t O_CTR = O_ROPE + (size_t)NTOK * 64 * 4;
constexpr size_t O_FAC = O_CTR + 4096;
constexpr size_t O_XBAR = O_FAC + (size_t)6144 * 3 * 128 * 4;
constexpr size_t O_BIG = O_XBAR + 16384;
constexpr size_t BIG_BYTES = (size_t)NTOK * (4864 + 768) * 2;
constexpr size_t WS_END = O_BIG + BIG_BYTES;
constexpr size_t O_ACTB = O_BIG + (size_t)32768 * 5632 * 2;

struct Args {
    const float* in[34];
    float* out;
    unsigned char* ws;
    int ph_lo, ph_hi;
};

typedef const __attribute__((address_space(4))) Args* AP;
DI int TID() { int t = threadIdx.x; asm volatile("" : "+v"(t)); return t; }
DI int BID() { int t = blockIdx.x; asm volatile("" : "+s"(t)); return t; }
DI int GDIM() { int t = gridDim.x; asm volatile("" : "+s"(t)); return t; }
DI float bf_lo(unsigned w) { return __uint_as_float(w << 16); }
DI float bf_hi(unsigned w) { return __uint_as_float(w & 0xffff0000u); }
DI float bf2f(bf16_t b) { return __uint_as_float(((unsigned)b) << 16); }
typedef float f32x2_t __attribute__((ext_vector_type(2)));
typedef __bf16 bf16x2_t __attribute__((ext_vector_type(2)));
DI unsigned pk2(float lo, float hi) { const f32x2_t v = {lo, hi}; const bf16x2_t b = __builtin_convertvector(v, bf16x2_t); return __builtin_bit_cast(unsigned, b); }
DI bf16_t f2bf(float f) { return (bf16_t)(pk2(f, f) & 0xffffu); }
DI void unpack8(const u32x4 w, float* f) {
    f[0] = bf_lo(w.x); f[1] = bf_hi(w.x); f[2] = bf_lo(w.y); f[3] = bf_hi(w.y);
    f[4] = bf_lo(w.z); f[5] = bf_hi(w.z); f[6] = bf_lo(w.w); f[7] = bf_hi(w.w);
}
DI u32x4 pack8(const float* f) { u32x4 w; w.x = pk2(f[0], f[1]); w.y = pk2(f[2], f[3]); w.z = pk2(f[4], f[5]); w.w = pk2(f[6], f[7]); return w; }
DI float sigmoidf_(float x) { return __builtin_amdgcn_rcpf(1.0f + __expf(-x)); }
DI float siluf_(float x) { return x * sigmoidf_(x); }
DI float wave_sum(float v) { for (int o = 32; o >= 1; o >>= 1) v += __shfl_xor(v, o); return v; }
#define MFMA16(a, b, c) __builtin_amdgcn_mfma_f32_16x16x32_bf16((a), (b), (c), 0, 0, 0)
DI void bar() { __syncthreads(); }
DI void bar_l() { asm volatile("s_waitcnt lgkmcnt(0)" ::: "memory"); __builtin_amdgcn_s_barrier(); asm volatile("" ::: "memory"); }

namespace pg8 {
constexpr int BM = 256, BK = 64, HALF = 128, HTB = HALF * BK * 2, STAGE_BYTES = 8 * HTB, NXCD = 8, WGM = 8;
DI int lds_byte(int r, int c) { const int st = (r >> 4) * 2 + (c >> 5), rr = r & 15, cc = c & 31, ob = rr * 64 + cc * 2; return st * 1024 + (ob ^ (((ob >> 9) & 1) << 5)); }
DI void stage_rc(int b, int& R, int& C) { const int st = b / 1024, sb = b % 1024, swz = sb ^ (((sb >> 9) & 1) << 5); R = (st >> 1) * 16 + swz / 64; C = (st & 1) * 32 + (swz % 64) / 2; }
DI int perm32(int rho) { const int n = rho >> 4, i = rho & 15; return 8 * (i >> 2) + 4 * n + (i & 3); }
struct Unit { int pm, pn; };
struct Gemm { const bf16_t* A; const bf16_t* Bt; int M, N, K; };
struct StaticOrder {
    int nM, nN, nwg, G, c;
    DI void init(int M, int N, int G_, int c_) { nM = M / BM; nN = N / BM; nwg = nM * nN; G = G_; c = c_; }
    DI bool next(int i, Unit& u) const {
        const long L = (long)i * G + c; if (L >= nwg) return false;
        int wgid = (int)L; { const int q = nwg / NXCD, r = nwg % NXCD, xcd = wgid % NXCD, off = wgid / NXCD; wgid = (xcd < r ? xcd * (q + 1) : r * (q + 1) + (xcd - r) * q) + off; }
        const int nig = WGM * nN, gid = wgid / nig, fm = gid * WGM, gsz = (nM - fm) < WGM ? (nM - fm) : WGM;
        u.pm = fm + ((wgid % nig) % gsz); u.pn = (wgid % nig) / gsz; return true;
    }
};
struct EpiScale {
    static constexpr bool PERM = true;
    bf16_t* O; int ldc; const float* ss;
    DI void operator()(const f32x4 (&acc)[2][2][4][2], const Unit& u, int wr, int wc, int fr, int fq) const {
        const int row0 = u.pm * BM + wr * 64 + fr, col0 = u.pn * BM + wc * 32 + 8 * fq;
        float sc[2][4];
        if (ss) {
            f32x4 pv[2][4];
#pragma unroll
            for (int ai = 0; ai < 2; ++ai)
#pragma unroll
                for (int m = 0; m < 4; ++m) pv[ai][m] = *(const f32x4*)(ss + (size_t)(row0 + ai * HALF + m * 16) * 16 + fq * 4);
#pragma unroll
            for (int ai = 0; ai < 2; ++ai)
#pragma unroll
                for (int m = 0; m < 4; ++m) { float t = (pv[ai][m][0] + pv[ai][m][1]) + (pv[ai][m][2] + pv[ai][m][3]);
                    t += __shfl_xor(t, 16); t += __shfl_xor(t, 32); sc[ai][m] = rsqrtf(t * (1.0f / 1024.0f) + EPS); }
        } else {
#pragma unroll
            for (int ai = 0; ai < 2; ++ai)
#pragma unroll
                for (int m = 0; m < 4; ++m) sc[ai][m] = 1.0f;
        }
#pragma unroll
        for (int ai = 0; ai < 2; ++ai)
#pragma unroll
            for (int m = 0; m < 4; ++m) {
                const int row = row0 + ai * HALF + m * 16;
                bf16_t* rowp = O + (size_t)row * ldc + col0;
#pragma unroll
                for (int bj = 0; bj < 2; ++bj) {
                    const f32x4 v0 = acc[ai][bj][m][0] * sc[ai][m], v1 = acc[ai][bj][m][1] * sc[ai][m];
                    u32x4 w; w.x = pk2(v0[0], v0[1]); w.y = pk2(v0[2], v0[3]); w.z = pk2(v1[0], v1[1]); w.w = pk2(v1[2], v1[3]);
                    *(u32x4*)(rowp + bj * HALF) = w;
                }
            }
    }
};
struct EpiResid {
    static constexpr bool PERM = false;
    bf16_t* xb; float* fout; float* ssn;
    DI void operator()(const f32x4 (&acc)[2][2][4][2], const Unit& u, int wr, int wc, int fr, int fq) const {
        const int row0 = u.pm * BM + wr * 64 + fr, col0 = u.pn * BM + wc * 32 + 4 * fq;
        u32x2 xi[2][4][2][2];
#pragma unroll
        for (int ai = 0; ai < 2; ++ai)
#pragma unroll
            for (int m = 0; m < 4; ++m)
#pragma unroll
                for (int bj = 0; bj < 2; ++bj)
#pragma unroll
                    for (int n = 0; n < 2; ++n) xi[ai][m][bj][n] = *(const u32x2*)(xb + (size_t)(row0 + ai * HALF + m * 16) * 1024 + col0 + bj * HALF + n * 16);
#pragma unroll
        for (int ai = 0; ai < 2; ++ai) {
#pragma unroll
            for (int m = 0; m < 4; ++m) {
                const int row = row0 + ai * HALF + m * 16;
                const size_t off = (size_t)row * 1024 + col0;
                float s = 0.f;
#pragma unroll
                for (int bj = 0; bj < 2; ++bj)
#pragma unroll
                    for (int n = 0; n < 2; ++n) {
                        const size_t o2 = off + bj * HALF + n * 16;
                        f32x4 o; o[0] = bf_lo(xi[ai][m][bj][n].x); o[1] = bf_hi(xi[ai][m][bj][n].x); o[2] = bf_lo(xi[ai][m][bj][n].y); o[3] = bf_hi(xi[ai][m][bj][n].y);
                        o += acc[ai][bj][m][n];
                        if (fout) *(f32x4*)(fout + o2) = o;
                        else { u32x2 w; w.x = pk2(o[0], o[1]); w.y = pk2(o[2], o[3]); *(u32x2*)(xb + o2) = w; }
                        s += (o[0] * o[0] + o[1] * o[1]) + (o[2] * o[2] + o[3] * o[3]);
                    }
                s += __shfl_xor(s, 16); s += __shfl_xor(s, 32);
                if (fq == 0 && ssn) ssn[(size_t)row * 16 + u.pn * 4 + wc] = s;
            }
        }
    }
};

template <class Epi>
DI void gemm_phase(LAS unsigned char* lds, const Gemm g, const StaticOrder& S, const Epi& E) {
    const int tid = TID(), wid = __builtin_amdgcn_readfirstlane(tid >> 6), lane = tid & 63, wr = wid >> 2, wc = wid & 3, fr = lane & 15, fq = lane >> 4;
    const int K = g.K, nt = K / BK;
    unsigned voffA[2], voffB[2];
#pragma unroll
    for (int i = 0; i < 2; ++i) { int R, C; stage_rc(tid * 16 + i * 8192, R, C); const int Rb = Epi::PERM ? ((R & ~31) + perm32(R & 31)) : R;
        voffA[i] = (unsigned)(R * K + C) * 2u; voffB[i] = (unsigned)(Rb * K + C) * 2u; }
    const size_t kstep = (size_t)(BK * 2);
    const size_t hstep = (size_t)HALF * K * 2;
    const size_t tstep = 2 * hstep;
    const unsigned ldsw = (unsigned)wid * 1024u;
    const int aoff = lds_byte(wr * 64 + fr, fq * 8), boff = lds_byte(wc * 32 + fr, fq * 8);
#define PG8_SA(b, h) (((b) * 2 + (h)) * HTB)
#define PG8_SB(b, h) ((4 + (b) * 2 + (h)) * HTB)
#define PG8_STAGE(bufoff, gbase, voff) do { _Pragma("unroll") for (int _i = 0; _i < 2; ++_i) \
        __builtin_amdgcn_global_load_lds((const unsigned*)((const char*)(gbase) + (voff)[_i]), (LAS unsigned*)(lds + (bufoff) + ldsw + _i * 8192), 16, 0, 0); } while (0)
#define PG8_LDA(dst, b, h) do { _Pragma("unroll") for (int m = 0; m < 4; ++m) _Pragma("unroll") for (int k = 0; k < 2; ++k) dst[m][k] = *(const LAS bf16x8*)(lds + PG8_SA(b, h) + aoff + m * 2048 + k * 1024); } while (0)
#define PG8_LDB(dst, b, h) do { _Pragma("unroll") for (int n = 0; n < 2; ++n) _Pragma("unroll") for (int k = 0; k < 2; ++k) dst[n][k] = *(const LAS bf16x8*)(lds + PG8_SB(b, h) + boff + n * 2048 + k * 1024); } while (0)
#define PG8_MMA(ai, bj, At, Bt) do { __builtin_amdgcn_s_setprio(1); _Pragma("unroll") for (int m = 0; m < 4; ++m) _Pragma("unroll") for (int n = 0; n < 2; ++n) _Pragma("unroll") for (int k = 0; k < 2; ++k) \
        acc[ai][bj][m][n] = __builtin_amdgcn_mfma_f32_16x16x32_bf16(Bt[n][k], At[m][k], acc[ai][bj][m][n], 0, 0, 0); __builtin_amdgcn_s_setprio(0); } while (0)
#define PG8_WAIT_V(n) asm volatile("s_waitcnt vmcnt(" #n ")" ::: "memory")
#define PG8_WAIT_L(n) asm volatile("s_waitcnt lgkmcnt(" #n ")" ::: "memory")
#define PG8_BAR __builtin_amdgcn_s_barrier()
#define PG8_SCHED __builtin_amdgcn_sched_barrier(0)
    Unit cur, nxt; int ui = 0;
    if (!S.next(0, cur)) return;
    f32x4 acc[2][2][4][2];
#pragma unroll
    for (int a = 0; a < 2; ++a)
#pragma unroll
        for (int b = 0; b < 2; ++b)
#pragma unroll
            for (int m = 0; m < 4; ++m)
#pragma unroll
                for (int n = 0; n < 2; ++n) acc[a][b][m][n] = (f32x4){0.f, 0.f, 0.f, 0.f};
    bf16x8 At[4][2], B0[2][2], B1[2][2];
    const char* cA = (const char*)g.A + (size_t)cur.pm * tstep; const char* cB = (const char*)g.Bt + (size_t)cur.pn * tstep;
    PG8_STAGE(PG8_SB(0, 0), cB, voffB); PG8_STAGE(PG8_SA(0, 0), cA, voffA); PG8_STAGE(PG8_SB(0, 1), cB + hstep, voffB); PG8_STAGE(PG8_SA(0, 1), cA + hstep, voffA);
    if (wr == 1) PG8_BAR;
    PG8_WAIT_V(4); PG8_BAR;
    PG8_STAGE(PG8_SB(1, 0), cB + kstep, voffB); PG8_STAGE(PG8_SA(1, 0), cA + kstep, voffA); PG8_STAGE(PG8_SB(1, 1), cB + hstep + kstep, voffB);
    PG8_WAIT_V(6); PG8_BAR;
    for (;;) {
        const bool has_next = S.next(ui + 1, nxt);
        const char* nA = has_next ? (const char*)g.A + (size_t)nxt.pm * tstep : cA; const char* nB = has_next ? (const char*)g.Bt + (size_t)nxt.pn * tstep : cB;
        for (int t = 0; t < nt; t += 2) {
            const bool last = (t == nt - 2);
            const char* a1 = cA + (size_t)(t + 1) * kstep;
            const char* a2 = last ? nA : cA + (size_t)(t + 2) * kstep; const char* b2 = last ? nB : cB + (size_t)(t + 2) * kstep;
            const char* a3 = a2 + kstep; const char* b3 = b2 + kstep;
            PG8_LDB(B0, 0, 0); PG8_SCHED; PG8_LDA(At, 0, 0); PG8_STAGE(PG8_SA(1, 1), a1 + hstep, voffA);
            PG8_WAIT_L(8); PG8_BAR; PG8_WAIT_L(0); PG8_MMA(0, 0, At, B0); PG8_BAR; PG8_SCHED;
            PG8_LDB(B1, 0, 1); PG8_STAGE(PG8_SB(0, 0), b2, voffB);
            PG8_BAR; PG8_WAIT_L(0); PG8_MMA(0, 1, At, B1); PG8_BAR;
            PG8_LDA(At, 0, 1); PG8_STAGE(PG8_SA(0, 0), a2, voffA);
            PG8_BAR; PG8_WAIT_L(0); PG8_MMA(1, 0, At, B0); PG8_BAR; PG8_SCHED;
            PG8_STAGE(PG8_SB(0, 1), b2 + hstep, voffB);
            PG8_WAIT_V(6); PG8_BAR; PG8_MMA(1, 1, At, B1); PG8_BAR;
            PG8_LDB(B0, 1, 0); PG8_SCHED; PG8_LDA(At, 1, 0); PG8_STAGE(PG8_SA(0, 1), a2 + hstep, voffA);
            PG8_WAIT_L(8); PG8_BAR; PG8_WAIT_L(0); PG8_MMA(0, 0, At, B0); PG8_BAR; PG8_SCHED;
            PG8_LDB(B1, 1, 1); PG8_STAGE(PG8_SB(1, 0), b3, voffB);
            PG8_BAR; PG8_WAIT_L(0); PG8_MMA(0, 1, At, B1); PG8_BAR;
            PG8_LDA(At, 1, 1); PG8_STAGE(PG8_SA(1, 0), a3, voffA);
            PG8_BAR; PG8_WAIT_L(0); PG8_MMA(1, 0, At, B0); PG8_BAR; PG8_SCHED;
            PG8_STAGE(PG8_SB(1, 1), b3 + hstep, voffB);
            PG8_WAIT_V(6); PG8_BAR; PG8_MMA(1, 1, At, B1); PG8_BAR;
        }
        E(acc, cur, wr, wc, fr, fq);
        if (!has_next) break;
#pragma unroll
        for (int a = 0; a < 2; ++a)
#pragma unroll
            for (int b = 0; b < 2; ++b)
#pragma unroll
                for (int m = 0; m < 4; ++m)
#pragma unroll
                    for (int n = 0; n < 2; ++n) acc[a][b][m][n] = (f32x4){0.f, 0.f, 0.f, 0.f};
        cur = nxt; cA = nA; cB = nB; ++ui;
    }
    PG8_WAIT_V(0);
    if (wr == 0) PG8_BAR;
    PG8_BAR;
#undef PG8_SA
#undef PG8_SB
#undef PG8_STAGE
#undef PG8_LDA
#undef PG8_LDB
#undef PG8_MMA
#undef PG8_WAIT_V
#undef PG8_WAIT_L
#undef PG8_BAR
#undef PG8_SCHED
}
}

DI void wconv(LAS unsigned char* lds, const float* src, int ldsrc, int c0, int ncols, const float* gain, bf16_t* dst, int r0, int K, int& tilebase) {
    LAS float* T = (LAS float*)lds;
    const int tid = TID(), ntn = (ncols + 63) >> 6, ntk = K >> 6, ntile = ntn * ntk;
    const int G = GDIM();
    int first = (BID() - (tilebase % G) + G) % G;
    for (int tile = first; tile < ntile; tile += G) {
        const int tk = tile / ntn, tn = tile % ntn, k0 = tk * 64, n0 = tn * 64;
        const int kk = tid >> 4, j4 = (tid & 15) * 4;
#pragma unroll
        for (int p = 0; p < 2; ++p) {
            const int k = kk + 32 * p, n = n0 + j4;
            f32x4 v = (f32x4){0.f, 0.f, 0.f, 0.f};
            if (n < ncols) v = *(const f32x4*)(src + (size_t)(k0 + k) * ldsrc + c0 + n);
            const float gsc = gain ? gain[k0 + k] : 1.0f;
            T[k * 65 + j4 + 0] = v[0] * gsc; T[k * 65 + j4 + 1] = v[1] * gsc; T[k * 65 + j4 + 2] = v[2] * gsc; T[k * 65 + j4 + 3] = v[3] * gsc;
        }
        bar();
        const int n = tid >> 3, k8 = (tid & 7) * 8;
        if (n0 + n < ncols) {
            float f[8];
#pragma unroll
            for (int q = 0; q < 8; ++q) f[q] = T[(k8 + q) * 65 + n];
            *(u32x4*)(dst + (size_t)(r0 + n0 + n) * K + k0 + k8) = pack8(f);
        }
        bar();
    }
    tilebase += ntile;
}

DI void prologue(AP a, LAS unsigned char* lds) {
    const int tid = TID(), lane = tid & 63, wid = tid >> 6;
    const size_t gtid = (size_t)BID() * 512 + tid, gsz = (size_t)GDIM() * 512;
    unsigned char* ws = a->ws;
    { f32x4 z = (f32x4){0.f, 0.f, 0.f, 0.f};
      f32x4* pc = (f32x4*)(ws + O_CTR); for (size_t i = gtid; i < 4096 / 16; i += gsz) pc[i] = z;
      f32x4* p0 = (f32x4*)(ws + O_WIN0 + (size_t)2576 * 1024 * 2); for (size_t i = gtid; i < (size_t)(NPAD0 - 2576) * 1024 * 2 / 16; i += gsz) p0[i] = z;
      f32x4* p2 = (f32x4*)(ws + O_WIN2 + (size_t)2316 * 1024 * 2); for (size_t i = gtid; i < (size_t)(NPAD2 - 2316) * 1024 * 2 / 16; i += gsz) p2[i] = z; }
    { const float* x = a->in[0]; bf16_t* xb = (bf16_t*)(ws + O_XB); float* ss0 = (float*)(ws + O_SS);
      for (int row = BID() * 8 + wid; row < NTOK; row += GDIM() * 16) {
          const int row2 = row + GDIM() * 8; const bool ok2 = row2 < NTOK;
          f32x4 va[4], vb[4];
#pragma unroll
          for (int i = 0; i < 4; ++i) { va[i] = ((const f32x4*)(x + (size_t)row * 1024))[lane + 64 * i]; vb[i] = ((const f32x4*)(x + (size_t)(ok2 ? row2 : row) * 1024))[lane + 64 * i]; }
          float s = 0.f, s2 = 0.f;
#pragma unroll
          for (int i = 0; i < 4; ++i) { s += va[i][0] * va[i][0] + va[i][1] * va[i][1] + va[i][2] * va[i][2] + va[i][3] * va[i][3]; s2 += vb[i][0] * vb[i][0] + vb[i][1] * vb[i][1] + vb[i][2] * vb[i][2] + vb[i][3] * vb[i][3];
              u32x2 w; w.x = pk2(va[i][0], va[i][1]); w.y = pk2(va[i][2], va[i][3]); *(u32x2*)(xb + (size_t)row * 1024 + (lane + 64 * i) * 4) = w;
              if (ok2) { u32x2 w2; w2.x = pk2(vb[i][0], vb[i][1]); w2.y = pk2(vb[i][2], vb[i][3]); *(u32x2*)(xb + (size_t)row2 * 1024 + (lane + 64 * i) * 4) = w2; } }
          s = wave_sum(s); s2 = wave_sum(s2);
          if (lane < 16) { ss0[(size_t)row * 16 + lane] = lane == 0 ? s : 0.f; if (ok2) ss0[(size_t)row2 * 16 + lane] = lane == 0 ? s2 : 0.f; }
      }
      const float* mem = a->in[1]; bf16_t* mn = (bf16_t*)(ws + O_MEMN);
      for (int row = BID() * 8 + wid; row < 2048; row += GDIM() * 8) {
          const f32x4* p = (const f32x4*)(mem + (size_t)row * 1024); float s = 0.f; f32x4 v[4];
#pragma unroll
          for (int i = 0; i < 4; ++i) { v[i] = p[lane + 64 * i]; s += v[i][0] * v[i][0] + v[i][1] * v[i][1] + v[i][2] * v[i][2] + v[i][3] * v[i][3]; }
          s = wave_sum(s); const float sc = rsqrtf(s * (1.0f / 1024.0f) + EPS);
#pragma unroll
          for (int i = 0; i < 4; ++i) { u32x2 w; w.x = pk2(v[i][0] * sc, v[i][1] * sc); w.y = pk2(v[i][2] * sc, v[i][3] * sc); *(u32x2*)(mn + (size_t)row * 1024 + (lane + 64 * i) * 4) = w; }
      } }
    { const int* pos = (const int*)a->in[2]; unsigned* rp = (unsigned*)(ws + O_ROPE);
      for (size_t i = gtid; i < (size_t)NTOK * 64; i += gsz) {
          const int row = (int)(i >> 6), j = (int)(i & 63);
          const float invf = exp2f(-(float)j * (13.287712379549449f / 64.0f));
          double rev = (double)pos[row] * (double)invf * 0.15915494309189535;
          rev = rev - floor(rev);
          const float fr = (float)rev;
          const float c = __builtin_amdgcn_cosf(fr), s = __builtin_amdgcn_sinf(fr);
          const _Float16 hc = (_Float16)c, hs = (_Float16)s;
          rp[i] = (unsigned)__builtin_bit_cast(unsigned short, hc) | ((unsigned)__builtin_bit_cast(unsigned short, hs) << 16);
      } }
    int tb = 0;
    const float* mixn = a->in[4]; const float* ffnn = a->in[8];
    wconv(lds, a->in[13], 2576, 0, 2576, mixn + 0 * 1024, (bf16_t*)(ws + O_WIN0), 0, 1024, tb);
    wconv(lds, a->in[18], 4864, 0, 4864, mixn + 1 * 1024, (bf16_t*)(ws + O_WIN1), 0, 1024, tb);
    wconv(lds, a->in[22], 2316, 0, 2048, mixn + 2 * 1024, (bf16_t*)(ws + O_WIN2), 0, 1024, tb);
    wconv(lds, a->in[22], 2316, 2060, 256, mixn + 2 * 1024, (bf16_t*)(ws + O_WIN2), 2048, 1024, tb);
    wconv(lds, a->in[22], 2316, 2048, 12, mixn + 2 * 1024, (bf16_t*)(ws + O_WIN2), 2304, 1024, tb);
    wconv(lds, a->in[30], 3328, 0, 3328, mixn + 3 * 1024, (bf16_t*)(ws + O_WIN3), 0, 1024, tb);
    wconv(lds, a->in[17], 1024, 0, 1024, nullptr, (bf16_t*)(ws + O_WOUT0), 0, 1024, tb);
    wconv(lds, a->in[21], 1024, 0, 1024, nullptr, (bf16_t*)(ws + O_WOUT1), 0, 768, tb);
    wconv(lds, a->in[29], 1024, 0, 1024, nullptr, (bf16_t*)(ws + O_WOUT2), 0, 1024, tb);
    wconv(lds, a->in[33], 1024, 0, 1024, nullptr, (bf16_t*)(ws + O_WOUT3), 0, 1024, tb);
    for (int l = 0; l < 4; ++l) {
        wconv(lds, a->in[9] + (size_t)l * 1024 * 5632, 5632, 0, 5632, ffnn + l * 1024, (bf16_t*)(ws + O_WUP) + (size_t)l * 5632 * 1024, 0, 1024, tb);
        wconv(lds, a->in[12] + (size_t)l * 2816 * 1024, 1024, 0, 1024, nullptr, (bf16_t*)(ws + O_WDN) + (size_t)l * 1024 * 2816, 0, 2816, tb);
        wconv(lds, a->in[5] + (size_t)l * 1024 * 512, 512, 0, 512, a->in[3], (bf16_t*)(ws + O_WKV), l * 512, 1024, tb);
    }
}

template <int HD, bool DIL>
struct AttnCfg {
    static constexpr int KSP = HD + 8;
    static constexpr int VTP = 320;
    static constexpr int KS_BYTES = 256 * KSP * 2;
    static constexpr int VT_OFF = KS_BYTES;
    static constexpr int NKT = DIL ? 9 : 16;
    static constexpr int NKS = (NKT + 1) / 2;
    static constexpr int NS = HD / 32;
    static constexpr int NDT = HD / 16;
};
DI int vt_swz(int d, int key) { return key ^ (((d >> 3) & 15) << 2); }

template <int STEP, int BASE>
DI void tr_read4(unsigned addr, s16x4 (&o)[4]) {
    asm volatile("ds_read_b64_tr_b16 %0, %4 offset:%5\n\tds_read_b64_tr_b16 %1, %4 offset:%6\n\tds_read_b64_tr_b16 %2, %4 offset:%7\n\tds_read_b64_tr_b16 %3, %4 offset:%8\n\ts_waitcnt lgkmcnt(0)"
                 : "=&v"(o[0]), "=&v"(o[1]), "=&v"(o[2]), "=&v"(o[3]) : "v"(addr), "n"(BASE), "n"(BASE + STEP), "n"(BASE + 2 * STEP), "n"(BASE + 3 * STEP) : "memory");
}

template <int HD, bool DIL>
DI void attn_tile(LAS unsigned char* lds, const bf16_t* qsrc, size_t qstride, const bf16_t* ksrc, const bf16_t* vsrc, size_t kstride,
                  const float* qg, const float* kg, const unsigned* ropeq, size_t ropeq_stride, const unsigned* ropek, size_t ropek_stride,
                  int nblk  , bf16_t* osrc, size_t ostride, float* lse, size_t lse_stride, bool wr = true) {
    typedef AttnCfg<HD, DIL> C;
    const int tid = TID(), lane = tid & 63, wid = tid >> 6, r = lane & 15, q = lane >> 4;
    LAS bf16_t* KS = (LAS bf16_t*)lds;
    LAS bf16_t* VT = (LAS bf16_t*)(lds + C::VT_OFF);
    bar();
    constexpr int VPR = HD / 8;
    constexpr int NIT = 256 * VPR / 512;
    const int qrow = 16 * wid + r;
    u32x4 qraw[C::NS], qc0[2], qc1[2];
#pragma unroll
    for (int s = 0; s < C::NS; ++s) qraw[s] = *(const u32x4*)(qsrc + (size_t)qrow * qstride + 32 * s + 8 * q);
    if (DIL) {
#pragma unroll
        for (int s = 0; s < 2; ++s) { qc0[s] = *(const u32x4*)(ropeq + (size_t)qrow * ropeq_stride + 32 * s + 8 * q); qc1[s] = *(const u32x4*)(ropeq + (size_t)qrow * ropeq_stride + 32 * s + 8 * q + 4); }
    }
    float kgv[8];
#pragma unroll
    for (int i = 0; i < 8; ++i) kgv[i] = kg[(tid % VPR) * 8 + i];
#pragma unroll
    for (int bb = 0; bb < NIT; bb += 4) {
        u32x4 kwv[4], vwv[4], cwv[4], cw2v[4];
#pragma unroll
        for (int u = 0; u < 4; ++u) {
            const int e = tid + 512 * (bb + u); const int key = e / VPR, dv = e % VPR;
            const bool valid = !DIL || nblk > 0 || key >= 128;
            const long krow = DIL ? (long)key - 128 : (long)key;
            kwv[u] = (u32x4){0u, 0u, 0u, 0u}; vwv[u] = kwv[u]; cwv[u] = kwv[u]; cw2v[u] = kwv[u];
            if (valid) { kwv[u] = *(const u32x4*)(ksrc + krow * (long)kstride + dv * 8); vwv[u] = *(const u32x4*)(vsrc + krow * (long)kstride + dv * 8);
                if (DIL) { cwv[u] = *(const u32x4*)(ropek + krow * (long)ropek_stride + (dv & 7) * 8); cw2v[u] = *(const u32x4*)(ropek + krow * (long)ropek_stride + (dv & 7) * 8 + 4); } }
        }
#pragma unroll
        for (int u = 0; u < 4; ++u) {
            const int e = tid + 512 * (bb + u); const int key = e / VPR, dv = e % VPR;
            float kf[8]; unpack8(kwv[u], kf);
            float ssq = 0.f;
#pragma unroll
            for (int i = 0; i < 8; ++i) ssq += kf[i] * kf[i];
#pragma unroll
            for (int o = 1; o < VPR; o <<= 1) ssq += __shfl_xor(ssq, o);
            const float sc = rsqrtf(ssq * (1.0f / HD) + EPS);
#pragma unroll
            for (int i = 0; i < 8; ++i) kf[i] *= sc * kgv[i];
            if (DIL) {
                float pf[8];
#pragma unroll
                for (int i = 0; i < 8; ++i) pf[i] = __shfl_xor(kf[i], 8);
                const unsigned cs[8] = {cwv[u].x, cwv[u].y, cwv[u].z, cwv[u].w, cw2v[u].x, cw2v[u].y, cw2v[u].z, cw2v[u].w};
#pragma unroll
                for (int i = 0; i < 8; ++i) {
                    const float c = (float)__builtin_bit_cast(_Float16, (unsigned short)(cs[i] & 0xffffu)), sn = (float)__builtin_bit_cast(_Float16, (unsigned short)(cs[i] >> 16));
                    kf[i] = (dv < 8) ? (kf[i] * c - pf[i] * sn) : (kf[i] * c + pf[i] * sn);
                }
            }
            *(LAS u32x4*)(KS + key * C::KSP + dv * 8) = pack8(kf);
            *(LAS u32x4*)(VT + key * C::KSP + dv * 8) = vwv[u];
        }
    }
    float qf[C::NS][8];
    { float ssq = 0.f;
#pragma unroll
      for (int s = 0; s < C::NS; ++s) { unpack8(qraw[s], qf[s]);
#pragma unroll
          for (int i = 0; i < 8; ++i) ssq += qf[s][i] * qf[s][i]; }
      ssq += __shfl_xor(ssq, 16); ssq += __shfl_xor(ssq, 32);
      const float sc = rsqrtf(ssq * (1.0f / HD) + EPS);
#pragma unroll
      for (int s = 0; s < C::NS; ++s)
#pragma unroll
          for (int i = 0; i < 8; ++i) qf[s][i] *= sc * qg[32 * s + 8 * q + i];
      if (DIL) {
#pragma unroll
          for (int s = 0; s < 2; ++s) {
              const u32x4 c0 = qc0[s], c1 = qc1[s];
              const unsigned cs[8] = {c0.x, c0.y, c0.z, c0.w, c1.x, c1.y, c1.z, c1.w};
#pragma unroll
              for (int i = 0; i < 8; ++i) {
                  const float c = (float)__builtin_bit_cast(_Float16, (unsigned short)(cs[i] & 0xffffu)), sn = (float)__builtin_bit_cast(_Float16, (unsigned short)(cs[i] >> 16));
                  const float x1 = qf[s][i], x2 = qf[s + 2][i];
                  qf[s][i] = x1 * c - x2 * sn; qf[s + 2][i] = x2 * c + x1 * sn;
              }
          }
      }
      const float qs = 1.4426950408889634f * (HD == 128 ? 0.08838834764831845f : 0.125f);
#pragma unroll
      for (int s = 0; s < C::NS; ++s)
#pragma unroll
          for (int i = 0; i < 8; ++i) qf[s][i] *= qs;
    }
    bf16x8 qfrag[C::NS];
#pragma unroll
    for (int s = 0; s < C::NS; ++s) { const u32x4 w = pack8(qf[s]); qfrag[s] = __builtin_bit_cast(bf16x8, w); }
    bar();
    const int kt0 = DIL ? wid : 0;
    f32x4 sacc[C::NKT];
#pragma unroll
    for (int t = 0; t < C::NKT; ++t) {
        sacc[t] = (f32x4){0.f, 0.f, 0.f, 0.f};
#pragma unroll
        for (int s = 0; s < C::NS; ++s) {
            const bf16x8 kfr = *(const LAS bf16x8*)(KS + ((kt0 + t) * 16 + r) * C::KSP + 32 * s + 8 * q);
            sacc[t] = MFMA16(kfr, qfrag[s], sacc[t]);
        }
    }
    float mx = -3.0e38f;
#pragma unroll
    for (int t = 0; t < C::NKT; ++t)
#pragma unroll
        for (int i = 0; i < 4; ++i) {
            if (DIL) { const int j = (kt0 + t) * 16 + 4 * q + i, dist = 128 + qrow - j; const bool ok = dist >= 0 && dist <= 128 && (nblk > 0 || j >= 128); if (!ok) sacc[t][i] = -3.0e38f; }
            mx = fmaxf(mx, sacc[t][i]);
        }
    mx = fmaxf(mx, __shfl_xor(mx, 16)); mx = fmaxf(mx, __shfl_xor(mx, 32));
    float l = 0.f;
#pragma unroll
    for (int t = 0; t < C::NKT; ++t)
#pragma unroll
        for (int i = 0; i < 4; ++i) { const float p = __builtin_amdgcn_exp2f(sacc[t][i] - mx); sacc[t][i] = p; l += p; }
    l += __shfl_xor(l, 16); l += __shfl_xor(l, 32);
    f32x4 oacc[C::NDT];
#pragma unroll
    for (int dt = 0; dt < C::NDT; ++dt) oacc[dt] = (f32x4){0.f, 0.f, 0.f, 0.f};
#pragma unroll
    for (int s = 0; s < C::NKS; ++s) {
        const bool has2 = (2 * s + 1) < C::NKT;
        u32x4 pw; pw.x = pk2(sacc[2 * s][0], sacc[2 * s][1]); pw.y = pk2(sacc[2 * s][2], sacc[2 * s][3]);
        if (has2) { pw.z = pk2(sacc[(2 * s + 1) < C::NKT ? 2 * s + 1 : 0][0], sacc[(2 * s + 1) < C::NKT ? 2 * s + 1 : 0][1]); pw.w = pk2(sacc[(2 * s + 1) < C::NKT ? 2 * s + 1 : 0][2], sacc[(2 * s + 1) < C::NKT ? 2 * s + 1 : 0][3]); }
        else { pw.z = 0u; pw.w = 0u; }
        const bf16x8 pfrag = __builtin_bit_cast(bf16x8, pw);
        const int key0 = (kt0 + 2 * s) * 16 + 4 * q, key1 = has2 ? key0 + 16 : key0;
        (void)key1;
        const unsigned vaddr = (unsigned)(size_t)(VT + (key0 + (r >> 2)) * C::KSP + 4 * (r & 3));
#pragma unroll
        for (int dg = 0; dg < C::NDT; dg += 4) {
            s16x4 lo[4], hi[4];
            if (dg == 0) { tr_read4<32, 0>(vaddr, lo); if (has2) tr_read4<32, 16 * C::KSP * 2>(vaddr, hi); else tr_read4<32, 0>(vaddr, hi); }
            else         { tr_read4<32, 128>(vaddr, lo); if (has2) tr_read4<32, 16 * C::KSP * 2 + 128>(vaddr, hi); else tr_read4<32, 128>(vaddr, hi); }
#pragma unroll
            for (int j = 0; j < 4; ++j) { const bf16x8 va = __builtin_shufflevector(lo[j], hi[j], 0, 1, 2, 3, 4, 5, 6, 7); oacc[dg + j] = MFMA16(va, pfrag, oacc[dg + j]); }
        }
    }
    const float il = __builtin_amdgcn_rcpf(l);
#pragma unroll
    for (int dt = 0; dt < C::NDT; ++dt) {
        const f32x4 o = oacc[dt] * il;
        u32x2 w; w.x = pk2(o[0], o[1]); w.y = pk2(o[2], o[3]);
        if (wr) *(u32x2*)(osrc + (size_t)qrow * ostride + dt * 16 + 4 * q) = w;
    }
    if (DIL && q == 0 && wr) lse[(size_t)qrow * lse_stride] = (mx + __builtin_amdgcn_logf(l)) * 0.6931471805599453f;
}

DI void xa_tile(AP a, LAS unsigned char* lds, int layer, int t_, const bf16_t* proj, int ldp, int xqcol, bf16_t* mix, int ldm, int xacol) {
    const int t = t_ & 2047; const int qt = t & 63, h = (t >> 6) & 3, b = t >> 8;
    const bf16_t* kvm = (const bf16_t*)(a->ws + O_KVM);
    const size_t row0 = (size_t)b * SEQ + (size_t)qt * 128;
    attn_tile<64, false>(lds, proj + row0 * ldp + xqcol + h * 64, (size_t)ldp,
                         kvm + (size_t)(b * 256) * 2048 + layer * 512 + h * 64, kvm + (size_t)(b * 256) * 2048 + layer * 512 + 256 + h * 64, 2048,
                         a->in[6] + layer * 64, a->in[7] + layer * 64, nullptr, 0, nullptr, 0, 1,
                         mix + row0 * ldm + xacol + h * 64, (size_t)ldm, nullptr, 0);
}
DI void dil_tile(AP a, LAS unsigned char* lds, int t_, bf16_t* proj) {
    const int t = t_ % 6144; const bool wr = t_ >= 6144 * (DUP_DIL - 1);
    const int blk = t & 63, hh = (t >> 6) % 12, b = t / 768;
    const int g = hh >> 2, rr = (g == 0) ? 1 : (g == 1 ? 4 : 16);
    const int nb = 64 / rr;
    const int rho = blk / nb, n = blk % nb;
    const size_t tok0 = (size_t)b * SEQ + rho + (size_t)rr * 128 * n;
    const unsigned* rope = (const unsigned*)(a->ws + O_ROPE);
    float* lse = (float*)(a->ws + O_LSE) + ((size_t)g * NTOK + tok0) * 4 + (hh & 3);
    bf16_t* qp = proj + tok0 * 4864 + hh * 128;
    attn_tile<128, true>(lds, qp, (size_t)rr * 4864, proj + tok0 * 4864 + 1536 + hh * 128, proj + tok0 * 4864 + 3072 + hh * 128, (size_t)rr * 4864,
                         a->in[19], a->in[20], rope + tok0 * 64, (size_t)rr * 64, rope + tok0 * 64, (size_t)rr * 64, n,
                         qp, (size_t)rr * 4864, lse, (size_t)rr * 4, wr);
}

DI int tsw(int row, int t) { return ((((t >> 3) ^ (row >> 3)) & 7) << 3) | (t & 7); }

template <int KIND>
DI void scan_unit(AP a, LAS unsigned char* lds, int unit, const bf16_t* proj, bf16_t* mix) {
    constexpr int K = KIND == 0 ? 96 : 128;
    constexpr int V = KIND == 0 ? 192 : (KIND == 2 ? 64 : 128);
    constexpr int H = KIND == 0 ? 4 : (KIND == 2 ? 12 : 6);
    constexpr int NVS = V / 32, KP = K + 8, K8 = K / 8, NST = K / 32, NKT = K / 16;
    constexpr int LDP = KIND == 0 ? NPAD0 : (KIND == 2 ? NPAD2 : NPAD3);
    const int tid = TID(), lane = tid & 63, wid = tid >> 6, r = lane & 15, q = lane >> 4;
    const int vs = unit % NVS, h = (unit / NVS) % H, b = unit / (NVS * H);
    constexpr int B_QT = 0, B_KT = B_QT + 64 * KP * 2, B_QI = B_KT + 64 * KP * 2, B_KTT = B_QI + (KIND == 2 ? 64 * KP * 2 : 0),
                  B_VT = B_KTT + K * 72 * 2, B_ATT = B_VT + 32 * 72 * 2, B_ST = B_ATT + 64 * 72 * 2, B_FD = B_ST + 32 * KP * 2, B_FC = B_FD + K * 4,
                  B_X = B_FC + K * 4;
    LAS bf16_t* QT = (LAS bf16_t*)(lds + B_QT); LAS bf16_t* KT = (LAS bf16_t*)(lds + B_KT); LAS bf16_t* QI = (LAS bf16_t*)(lds + B_QI);
    LAS bf16_t* KTT = (LAS bf16_t*)(lds + B_KTT); LAS bf16_t* VT = (LAS bf16_t*)(lds + B_VT); LAS bf16_t* ATT = (LAS bf16_t*)(lds + B_ATT);
    LAS bf16_t* ST = (LAS bf16_t*)(lds + B_ST); LAS float* FD = (LAS float*)(lds + B_FD); LAS float* FC = (LAS float*)(lds + B_FC);
    LAS float* LA = (LAS float*)(lds + B_X);
    LAS float* BC = LA + 64 * K;
    LAS float* XT = BC + 64 * K;
    LAS bf16_t* RAW = (LAS bf16_t*)(lds + B_X);
    LAS float* CW = (LAS float*)(lds + B_X + 67 * 288 * 2 + 32);
    LAS float* CBs = CW + 4 * 288; LAS float* ACS = CBs + 288; LAS float* DTS = ACS + 64; LAS float* XS = DTS + 64;
    static_assert(B_X + (KIND == 2 ? 67 * 288 * 2 + 32 + (5 * 288 + 128 + 64 * 32) * 4 : (2 * 64 * K + 16 * 96 + 96 + 64 * 16) * 4) <= LDS_BYTES, "scan LDS");

    bar();
    float Ah = 0.f, Dh = 0.f, dtb = 0.f;
    if (KIND == 0) {
        const float* w2 = a->in[14]; const float* bg = a->in[15];
        for (int i = tid; i < 16 * 96; i += 512) XT[i] = w2[(i / 96) * 384 + h * 96 + (i % 96)];
        if (tid < 96) XT[16 * 96 + tid] = bg[h * 96 + tid];
    } else if (KIND == 3) {
        const float* lbp = a->in[31];
        if (tid < 128) { const int c = h * 128 + tid; const float v0 = lbp[c], v1 = lbp[768 + c], v2 = lbp[1536 + c], v3 = lbp[2304 + c];
            const float m = fmaxf(fmaxf(v0, v1), fmaxf(v2, v3)); const float e0 = __expf(v0 - m), e1 = __expf(v1 - m), e2 = __expf(v2 - m), e3 = __expf(v3 - m);
            XT[tid] = (e1 + e2 + e3) / (e0 + e1 + e2 + e3); }
    } else {
        const float* cw = a->in[23]; const float* cb = a->in[24];
        const int g = h / 6;
        for (int i = tid; i < 288; i += 512) { const int ch = i < 32 ? (h * 64 + vs * 32 + i) : (i < 160 ? 768 + g * 128 + (i - 32) : 1024 + g * 128 + (i - 160));
#pragma unroll
            for (int j = 0; j < 4; ++j) CW[j * 288 + i] = cw[j * 1280 + ch];
            CBs[i] = cb[ch]; }
        Ah = -__expf(a->in[26][h]); Dh = a->in[27][h]; dtb = a->in[25][h];
    }
    bar();
    f32x4 Sacc[2];
    Sacc[0] = (f32x4){0.f, 0.f, 0.f, 0.f}; Sacc[1] = Sacc[0];
    const size_t rowb = (size_t)b * SEQ;
    constexpr int QCOL = 0, KCOL = KIND == 0 ? 384 : 768  , VCOL = KIND == 0 ? 768 : 1536  ;

    for (int c = 0; c < SEQ / 64; ++c) {
        const size_t row0 = rowb + (size_t)c * 64;
        if (KIND != 2) {
            u32x4 qw[2], kw[2];
#pragma unroll
            for (int p = 0; p < 2; ++p) { const int e = tid + 512 * p; qw[p] = (u32x4){0u, 0u, 0u, 0u}; kw[p] = qw[p];
                if (e < 64 * K8) { const int t = e / K8, k8 = (e % K8) * 8; const bf16_t* rp = proj + (row0 + t) * LDP + h * K + k8;
                    qw[p] = *(const u32x4*)(rp + QCOL); kw[p] = *(const u32x4*)(rp + KCOL); } }
            u32x4 vw = (u32x4){0u, 0u, 0u, 0u};
            if (tid < 256) vw = *(const u32x4*)(proj + (row0 + (tid >> 2)) * LDP + VCOL + h * V + vs * 32 + (tid & 3) * 8);
            float omf[2][8];
            if (KIND == 0) {
                LAS float* GLR = XT + 16 * 96 + 96;
                if (tid < 128) { const int t = tid >> 1, hf = tid & 1; const u32x4 w = *(const u32x4*)(proj + (row0 + t) * LDP + 1536 + hf * 8); float f[8]; unpack8(w, f);
#pragma unroll
                    for (int i = 0; i < 8; ++i) GLR[t * 16 + hf * 8 + i] = f[i]; }
                bar();
#pragma unroll
                for (int p = 0; p < 2; ++p) { const int e = tid + 512 * p;
                    if (e < 64 * K8) { const int t = e / K8, k8 = (e % K8) * 8; float acc8[8];
#pragma unroll
                        for (int i = 0; i < 8; ++i) acc8[i] = XT[16 * 96 + k8 + i];
#pragma unroll
                        for (int rr = 0; rr < 16; ++rr) { const float gv = GLR[t * 16 + rr];
#pragma unroll
                            for (int i = 0; i < 8; ++i) acc8[i] += gv * XT[rr * 96 + k8 + i]; }
#pragma unroll
                        for (int i = 0; i < 8; ++i) { const float x = acc8[i]; LA[t * K + k8 + i] = (fminf(x, 0.f) - __logf(1.0f + __expf(-fabsf(x)))) * (1.0f / 16.0f); } } }
            } else {
#pragma unroll
                for (int p = 0; p < 2; ++p) { const int e = tid + 512 * p; const int t = e / K8, k8 = (e % K8) * 8; float f[8]; unpack8(kw[p], f);
#pragma unroll
                    for (int i = 0; i < 8; ++i) { const float lb = XT[k8 + i]; const float fg = lb + (1.0f - lb) * sigmoidf_(f[i]); omf[p][i] = 1.0f - fg; LA[t * K + k8 + i] = __logf(fg); } }
            }
            bar();
            for (int it = tid; it < K * 8; it += 512) { const int k = it % K, seg = it / K; float pre = 0.f;
                for (int t = 0; t < seg * 8; ++t) pre += LA[t * K + k];
#pragma unroll
                for (int i = 0; i < 8; ++i) { pre += LA[(seg * 8 + i) * K + k]; BC[(seg * 8 + i) * K + k] = pre; } }
            bar();
#pragma unroll
            for (int p = 0; p < 2; ++p) { const int e = tid + 512 * p;
                if (e < 64 * K8) { const int t = e / K8, k8 = (e % K8) * 8; float qv[8], kv[8]; unpack8(qw[p], qv); unpack8(kw[p], kv);
#pragma unroll
                    for (int i = 0; i < 8; ++i) { const float bb = BC[t * K + k8 + i], br = BC[31 * K + k8 + i]; const float ea = __expf(bb - br), eb = __expf(br - bb);
                        if (KIND == 0) { qv[i] = qv[i] * 0.10206207261596575f * ea; kv[i] = kv[i] * eb; }
                        else { qv[i] = siluf_(qv[i]) * ea; kv[i] = omf[p][i] * eb; } }
                    const u32x4 qp = pack8(qv), kp = pack8(kv);
                    *(LAS u32x4*)(QT + t * KP + k8) = qp; *(LAS u32x4*)(KT + t * KP + k8) = kp;
                    const unsigned kk[4] = {kp.x, kp.y, kp.z, kp.w};
#pragma unroll
                    for (int i = 0; i < 8; ++i) KTT[(k8 + i) * 72 + tsw(k8 + i, t)] = (bf16_t)((i & 1) ? (kk[i >> 1] >> 16) : (kk[i >> 1] & 0xffffu)); } }
            if (tid < 256) { const int t = tid >> 2, v8 = (tid & 3) * 8; const unsigned vv[4] = {vw.x, vw.y, vw.z, vw.w};
#pragma unroll
                for (int i = 0; i < 8; ++i) VT[(v8 + i) * 72 + tsw(v8 + i, t)] = (bf16_t)((i & 1) ? (vv[i >> 1] >> 16) : (vv[i >> 1] & 0xffffu)); }
            if (tid < K) { FD[tid] = __expf(BC[63 * K + tid]); FC[tid] = __expf(BC[63 * K + tid] - BC[31 * K + tid]); }
            if (wid < NKT) {
#pragma unroll
                for (int vt = 0; vt < 2; ++vt) { const int k0 = wid * 16 + q * 4; float s4[4];
#pragma unroll
                    for (int i = 0; i < 4; ++i) s4[i] = Sacc[vt][i] * __expf(BC[31 * K + k0 + i]);
                    u32x2 w; w.x = pk2(s4[0], s4[1]); w.y = pk2(s4[2], s4[3]); *(LAS u32x2*)(ST + (vt * 16 + r) * KP + k0) = w; } }
        } else {
            const int g = h / 6;
            for (int e = tid; e < 67 * 36; e += 512) { const int rw = e / 36, cv = e % 36; const long t = (long)c * 64 + rw - 3;
                const int col = cv < 4 ? (768 + h * 64 + vs * 32 + cv * 8) : (cv < 20 ? 1536 + g * 128 + (cv - 4) * 8 : 1792 + g * 128 + (cv - 20) * 8);
                u32x4 w = (u32x4){0u, 0u, 0u, 0u}; if (t >= 0) w = *(const u32x4*)(proj + (rowb + t) * LDP + col);
                *(LAS u32x4*)(RAW + rw * 288 + cv * 8) = w; }
            if (wid == 0) { const float dr = bf2f(proj[(row0 + lane) * LDP + 2304 + h]) + dtb; const float dt = dr > 20.f ? dr : __logf(1.0f + __expf(dr));
                float cs = dt * Ah;
#pragma unroll
                for (int o = 1; o < 64; o <<= 1) { const float n = __shfl_up(cs, o); if (lane >= o) cs += n; }
                ACS[lane] = cs; DTS[lane] = dt; }
            bar();
            const float acl = ACS[63];
            for (int e = tid; e < 64 * 36; e += 512) { const int t = e / 36, cv = e % 36; float val[8];
#pragma unroll
                for (int i = 0; i < 8; ++i) val[i] = CBs[cv * 8 + i];
#pragma unroll
                for (int j = 0; j < 4; ++j) { const u32x4 w = *(const LAS u32x4*)(RAW + (t + j) * 288 + cv * 8); float f[8]; unpack8(w, f);
#pragma unroll
                    for (int i = 0; i < 8; ++i) val[i] += CW[j * 288 + cv * 8 + i] * f[i]; }
#pragma unroll
                for (int i = 0; i < 8; ++i) val[i] = siluf_(val[i]);
                if (cv < 4) { const float dt = DTS[t];
#pragma unroll
                    for (int i = 0; i < 8; ++i) { XS[t * 32 + cv * 8 + i] = val[i]; VT[(cv * 8 + i) * 72 + tsw(cv * 8 + i, t)] = f2bf(val[i] * dt); } }
                else if (cv < 20) { const int k8 = (cv - 4) * 8; *(LAS u32x4*)(KT + t * KP + k8) = pack8(val); const float e2 = __expf(acl - ACS[t]);
#pragma unroll
                    for (int i = 0; i < 8; ++i) KTT[(k8 + i) * 72 + tsw(k8 + i, t)] = f2bf(val[i] * e2); }
                else { const int k8 = (cv - 20) * 8; *(LAS u32x4*)(QT + t * KP + k8) = pack8(val); const float e1 = __expf(ACS[t]);
#pragma unroll
                    for (int i = 0; i < 8; ++i) val[i] *= e1;
                    *(LAS u32x4*)(QI + t * KP + k8) = pack8(val); } }
            if (tid < K) { FD[tid] = __expf(acl); FC[tid] = 1.0f; }
#pragma unroll
            for (int vt = 0; vt < 2; ++vt) { const int k0 = wid * 16 + q * 4; u32x2 w; w.x = pk2(Sacc[vt][0], Sacc[vt][1]); w.y = pk2(Sacc[vt][2], Sacc[vt][3]); *(LAS u32x2*)(ST + (vt * 16 + r) * KP + k0) = w; }
        }
        bar();
        { const int it = wid >> 1;
#pragma unroll
          for (int jj = 0; jj < 2; ++jj) { const int jt = 2 * (wid & 1) + jj; f32x4 acc = (f32x4){0.f, 0.f, 0.f, 0.f};
#pragma unroll
              for (int s = 0; s < NST; ++s) { const bf16x8 kf = *(const LAS bf16x8*)(KT + (jt * 16 + r) * KP + 32 * s + 8 * q); const bf16x8 qf = *(const LAS bf16x8*)(QT + (it * 16 + r) * KP + 32 * s + 8 * q);
                  acc = MFMA16(kf, qf, acc); }
              const int i = it * 16 + r;
#pragma unroll
              for (int ii = 0; ii < 4; ++ii) { const int j = jt * 16 + 4 * q + ii; float v = acc[ii];
                  if (KIND == 2) v *= (j <= i) ? __expf(ACS[i] - ACS[j]) : 0.f;
                  acc[ii] = (j <= i) ? v : 0.f; }
              u32x2 w; w.x = pk2(acc[0], acc[1]); w.y = pk2(acc[2], acc[3]); *(LAS u32x2*)(ATT + i * 72 + jt * 16 + 4 * q) = w; } }
        bar();
        { const int it = wid >> 1, vt = wid & 1; f32x4 o = (f32x4){0.f, 0.f, 0.f, 0.f};
#pragma unroll
          for (int s = 0; s < 2; ++s) { const int vr = vt * 16 + r; const bf16x8 vf = *(const LAS bf16x8*)(VT + vr * 72 + tsw(vr, 32 * s + 8 * q)); const bf16x8 af = *(const LAS bf16x8*)(ATT + (it * 16 + r) * 72 + 32 * s + 8 * q);
              o = MFMA16(vf, af, o); }
          LAS bf16_t* QX = (KIND == 2) ? QI : QT;
#pragma unroll
          for (int s = 0; s < NST; ++s) { const bf16x8 sf = *(const LAS bf16x8*)(ST + (vt * 16 + r) * KP + 32 * s + 8 * q); const bf16x8 qf = *(const LAS bf16x8*)(QX + (it * 16 + r) * KP + 32 * s + 8 * q);
              o = MFMA16(sf, qf, o); }
          const int i = it * 16 + r, v0 = vt * 16 + 4 * q; const size_t row = row0 + i;
          if (KIND == 2) {
              const u32x2 zw = *(const u32x2*)(proj + row * LDP + h * 64 + vs * 32 + v0); const float z[4] = {bf_lo(zw.x), bf_hi(zw.x), bf_lo(zw.y), bf_hi(zw.y)};
#pragma unroll
              for (int ii = 0; ii < 4; ++ii) o[ii] = (o[ii] + Dh * XS[i * 32 + v0 + ii]) * siluf_(z[ii]);
          }
          u32x2 w; w.x = pk2(o[0], o[1]); w.y = pk2(o[2], o[3]);
          *(u32x2*)(mix + row * 1024 + h * V + vs * 32 + v0) = w;
        }
        if (wid < NKT) {
#pragma unroll
            for (int vt = 0; vt < 2; ++vt) { f32x4 d = (f32x4){0.f, 0.f, 0.f, 0.f};
#pragma unroll
                for (int s = 0; s < 2; ++s) { const int kr = wid * 16 + r, vr = vt * 16 + r;
                    const bf16x8 kf = *(const LAS bf16x8*)(KTT + kr * 72 + tsw(kr, 32 * s + 8 * q)); const bf16x8 vf = *(const LAS bf16x8*)(VT + vr * 72 + tsw(vr, 32 * s + 8 * q));
                    d = MFMA16(kf, vf, d); }
#pragma unroll
                for (int ii = 0; ii < 4; ++ii) { const int k = wid * 16 + 4 * q + ii; Sacc[vt][ii] = FD[k] * Sacc[vt][ii] + FC[k] * d[ii]; } }
        }
    }
}


template <int KIND>
DI void scan_pre(AP a, LAS unsigned char* lds, int item, bf16_t* proj, bf16_t* mix, float* fac, bool wrq = true) {
    constexpr int K = KIND == 0 ? 96 : 128;
    constexpr int V = KIND == 0 ? 192 : 128;
    constexpr int H = KIND == 0 ? 4 : 6;
    constexpr int KP = K + 8, K8 = K / 8, NST = K / 32, V8 = V / 8, NVT = V / 16;
    constexpr int LDP = KIND == 0 ? NPAD0 : NPAD3;
    const int tid = TID(), lane = tid & 63, wid = tid >> 6, r = lane & 15, q = lane >> 4;
    const int c = item & 127, h = (item >> 7) % H, b = item / (128 * H);
    constexpr int B_QT = 0, B_KT = B_QT + 64 * KP * 2, B_VT = B_KT + 64 * KP * 2, B_ATT = B_VT + V * 72 * 2, B_X = B_ATT + 64 * 72 * 2;
    LAS bf16_t* QT = (LAS bf16_t*)(lds + B_QT); LAS bf16_t* KT = (LAS bf16_t*)(lds + B_KT);
    LAS bf16_t* VT = (LAS bf16_t*)(lds + B_VT); LAS bf16_t* ATT = (LAS bf16_t*)(lds + B_ATT);
    LAS float* LA = (LAS float*)(lds + B_X); LAS float* BC = LA + 64 * K; LAS float* XT = BC + 64 * K;
    static_assert(B_X + (2 * 64 * K + 16 * 96 + 96 + 64 * 16) * 4 <= LDS_BYTES - 16, "scan_pre LDS");
    const size_t row0 = (size_t)b * SEQ + (size_t)c * 64;
    constexpr int QCOL = 0, KCOL = KIND == 0 ? 384 : 768, VCOL = KIND == 0 ? 768 : 1536;
    bar();
    if (KIND == 0) {
        const float* w2 = a->in[14]; const float* bg = a->in[15];
        for (int i = tid; i < 16 * 96; i += 512) XT[i] = w2[(i / 96) * 384 + h * 96 + (i % 96)];
        if (tid < 96) XT[16 * 96 + tid] = bg[h * 96 + tid];
        LAS float* GLR = XT + 16 * 96 + 96;
        if (tid < 128) { const int t = tid >> 1, hf = tid & 1; const u32x4 w = *(const u32x4*)(proj + (row0 + t) * LDP + 1536 + hf * 8); float f[8]; unpack8(w, f);
#pragma unroll
            for (int i = 0; i < 8; ++i) GLR[t * 16 + hf * 8 + i] = f[i]; }
    } else {
        const float* lbp = a->in[31];
        if (tid < 128) { const int cc = h * 128 + tid; const float v0 = lbp[cc], v1 = lbp[768 + cc], v2 = lbp[1536 + cc], v3 = lbp[2304 + cc];
            const float m = fmaxf(fmaxf(v0, v1), fmaxf(v2, v3)); const float e0 = __expf(v0 - m), e1 = __expf(v1 - m), e2 = __expf(v2 - m), e3 = __expf(v3 - m);
            XT[tid] = (e1 + e2 + e3) / (e0 + e1 + e2 + e3); }
    }
    u32x4 qw[2], kw[2];
#pragma unroll
    for (int p = 0; p < 2; ++p) { const int e = tid + 512 * p; qw[p] = (u32x4){0u, 0u, 0u, 0u}; kw[p] = qw[p];
        if (e < 64 * K8) { const int t = e / K8, k8 = (e % K8) * 8; const bf16_t* rp = proj + (row0 + t) * LDP + h * K + k8;
            qw[p] = *(const u32x4*)(rp + QCOL); kw[p] = *(const u32x4*)(rp + KCOL); } }
    for (int e = tid; e < 64 * V8; e += 512) { const int t = e / V8, v8 = (e % V8) * 8; const u32x4 vw = *(const u32x4*)(proj + (row0 + t) * LDP + VCOL + h * V + v8);
        const unsigned vv[4] = {vw.x, vw.y, vw.z, vw.w};
#pragma unroll
        for (int i = 0; i < 8; ++i) VT[(v8 + i) * 72 + tsw(v8 + i, t)] = (bf16_t)((i & 1) ? (vv[i >> 1] >> 16) : (vv[i >> 1] & 0xffffu)); }
    bar();
    float omf[2][8];
    if (KIND == 0) {
        LAS float* GLR = XT + 16 * 96 + 96;
#pragma unroll
        for (int p = 0; p < 2; ++p) { const int e = tid + 512 * p;
            if (e < 64 * K8) { const int t = e / K8, k8 = (e % K8) * 8; float acc8[8];
#pragma unroll
                for (int i = 0; i < 8; ++i) acc8[i] = XT[16 * 96 + k8 + i];
#pragma unroll
                for (int rr = 0; rr < 16; ++rr) { const float gv = GLR[t * 16 + rr];
#pragma unroll
                    for (int i = 0; i < 8; ++i) acc8[i] += gv * XT[rr * 96 + k8 + i]; }
#pragma unroll
                for (int i = 0; i < 8; ++i) { const float x = acc8[i]; LA[t * K + k8 + i] = (fminf(x, 0.f) - __logf(1.0f + __expf(-fabsf(x)))) * (1.0f / 16.0f); } } }
    } else {
#pragma unroll
        for (int p = 0; p < 2; ++p) { const int e = tid + 512 * p; const int t = e / K8, k8 = (e % K8) * 8; float f[8]; unpack8(kw[p], f);
#pragma unroll
            for (int i = 0; i < 8; ++i) { const float lb = XT[k8 + i]; const float fg = lb + (1.0f - lb) * sigmoidf_(f[i]); omf[p][i] = 1.0f - fg; LA[t * K + k8 + i] = __logf(fg); } }
    }
    bar();
    for (int it = tid; it < K * 8; it += 512) { const int k = it % K, seg = it / K; float pre = 0.f;
        for (int t = 0; t < seg * 8; ++t) pre += LA[t * K + k];
#pragma unroll
        for (int i = 0; i < 8; ++i) { pre += LA[(seg * 8 + i) * K + k]; BC[(seg * 8 + i) * K + k] = pre; } }
    bar();
#pragma unroll
    for (int p = 0; p < 2; ++p) { const int e = tid + 512 * p;
        if (e < 64 * K8) { const int t = e / K8, k8 = (e % K8) * 8; float qv[8], kv[8]; unpack8(qw[p], qv); unpack8(kw[p], kv);
#pragma unroll
            for (int i = 0; i < 8; ++i) { const float bb = BC[t * K + k8 + i], br = BC[31 * K + k8 + i]; const float ea = __expf(bb - br), eb = __expf(br - bb);
                if (KIND == 0) { qv[i] = qv[i] * 0.10206207261596575f * ea; kv[i] = kv[i] * eb; }
                else { qv[i] = siluf_(qv[i]) * ea; kv[i] = omf[p][i] * eb; } }
            const u32x4 qp = pack8(qv), kp = pack8(kv);
            *(LAS u32x4*)(QT + t * KP + k8) = qp; *(LAS u32x4*)(KT + t * KP + k8) = kp;
            bf16_t* rp = proj + (row0 + t) * LDP + h * K + k8;
            if (wrq) { *(u32x4*)(rp + QCOL) = qp; *(u32x4*)(rp + KCOL) = kp; } } }
    if (tid < K) { float* fp = fac + (size_t)item * 3 * K; const float b31 = BC[31 * K + tid], b63 = BC[63 * K + tid];
        fp[tid] = __expf(b31); fp[K + tid] = __expf(b63); fp[2 * K + tid] = __expf(b63 - b31); }
    bar();
    { const int it = wid >> 1;
#pragma unroll
      for (int jj = 0; jj < 2; ++jj) { const int jt = 2 * (wid & 1) + jj; f32x4 acc = (f32x4){0.f, 0.f, 0.f, 0.f};
#pragma unroll
          for (int s = 0; s < NST; ++s) { const bf16x8 kf = *(const LAS bf16x8*)(KT + (jt * 16 + r) * KP + 32 * s + 8 * q); const bf16x8 qf = *(const LAS bf16x8*)(QT + (it * 16 + r) * KP + 32 * s + 8 * q);
              acc = MFMA16(kf, qf, acc); }
          const int i = it * 16 + r;
#pragma unroll
          for (int ii = 0; ii < 4; ++ii) { const int j = jt * 16 + 4 * q + ii; acc[ii] = (j <= i) ? acc[ii] : 0.f; }
          u32x2 w; w.x = pk2(acc[0], acc[1]); w.y = pk2(acc[2], acc[3]); *(LAS u32x2*)(ATT + i * 72 + jt * 16 + 4 * q) = w; } }
    bar();
    { const int it = wid >> 1;
#pragma unroll
      for (int j = 0; j < NVT / 2; ++j) { const int vt = (wid & 1) + 2 * j; f32x4 o = (f32x4){0.f, 0.f, 0.f, 0.f};
#pragma unroll
          for (int s = 0; s < 2; ++s) { const int vr = vt * 16 + r; const bf16x8 vf = *(const LAS bf16x8*)(VT + vr * 72 + tsw(vr, 32 * s + 8 * q)); const bf16x8 af = *(const LAS bf16x8*)(ATT + (it * 16 + r) * 72 + 32 * s + 8 * q);
              o = MFMA16(vf, af, o); }
          u32x2 w; w.x = pk2(o[0], o[1]); w.y = pk2(o[2], o[3]);
          *(u32x2*)(mix + (row0 + it * 16 + r) * 1024 + h * V + vt * 16 + 4 * q) = w; } }
}

template <int KIND>
DI void scan_seq(AP a, LAS unsigned char* lds, int unit, const bf16_t* proj, bf16_t* mix, const float* fac) {
    constexpr int K = KIND == 0 ? 96 : 128;
    constexpr int V = KIND == 0 ? 192 : 128;
    constexpr int H = KIND == 0 ? 4 : 6;
    constexpr int NVS = V / 32, KP = K + 8, K8 = K / 8, NST = K / 32, NKT = K / 16;
    constexpr int LDP = KIND == 0 ? NPAD0 : NPAD3;
    const int tid = TID(), lane = tid & 63, wid = tid >> 6, r = lane & 15, q = lane >> 4;
    const int vs = unit % NVS, h = (unit / NVS) % H, b = unit / (NVS * H);
    constexpr int B_QT = 0, B_KTT = B_QT + 64 * KP * 2, B_VT = B_KTT + K * 72 * 2, B_ST = B_VT + 32 * 72 * 2;
    constexpr int SEQ_BUF = B_ST + 32 * KP * 2;
    LAS bf16_t* QT0 = (LAS bf16_t*)(lds + B_QT); LAS bf16_t* KTT0 = (LAS bf16_t*)(lds + B_KTT); LAS bf16_t* VT0 = (LAS bf16_t*)(lds + B_VT); LAS bf16_t* ST0 = (LAS bf16_t*)(lds + B_ST);
    constexpr int QCOL = 0, KCOL = KIND == 0 ? 384 : 768, VCOL = KIND == 0 ? 768 : 1536;
    const size_t rowb = (size_t)b * SEQ;
    const int it = wid >> 1, vt = wid & 1;
    const int item0 = (b * H + h) * 128;
    f32x4 Sacc[2]; Sacc[0] = (f32x4){0.f, 0.f, 0.f, 0.f}; Sacc[1] = Sacc[0];
    struct RS { u32x4 qw[2], kw[2], vw; u32x2 oi; f32x4 fe, fd, fc; };
    RS A, B;
#define SEQ_LOAD(R, cc) do { const size_t row0_ = rowb + (size_t)(cc) * 64; \
        _Pragma("unroll") for (int p = 0; p < 2; ++p) { const int e = tid + 512 * p; R.qw[p] = (u32x4){0u, 0u, 0u, 0u}; R.kw[p] = R.qw[p]; \
            if (e < 64 * K8) { const int t = e / K8, k8 = (e % K8) * 8; const bf16_t* rp = proj + (row0_ + t) * LDP + h * K + k8; R.qw[p] = *(const u32x4*)(rp + QCOL); R.kw[p] = *(const u32x4*)(rp + KCOL); } } \
        R.vw = (u32x4){0u, 0u, 0u, 0u}; if (tid < 256) R.vw = *(const u32x4*)(proj + (row0_ + (tid >> 2)) * LDP + VCOL + h * V + vs * 32 + (tid & 3) * 8); \
        R.oi = *(const u32x2*)(mix + (row0_ + it * 16 + r) * 1024 + h * V + vs * 32 + vt * 16 + 4 * q); \
        R.fe = (f32x4){0.f, 0.f, 0.f, 0.f}; R.fd = R.fe; R.fc = R.fe; \
        if (wid < NKT) { const float* fp = fac + (size_t)(item0 + (cc)) * 3 * K + wid * 16 + 4 * q; R.fe = *(const f32x4*)fp; R.fd = *(const f32x4*)(fp + K); R.fc = *(const f32x4*)(fp + 2 * K); } } while (0)
#define SEQ_BODY(R, c, PB) do { \
        LAS bf16_t* QT = QT0 + (PB) * (SEQ_BUF / 2); LAS bf16_t* KTT = KTT0 + (PB) * (SEQ_BUF / 2); LAS bf16_t* VT = VT0 + (PB) * (SEQ_BUF / 2); LAS bf16_t* ST = ST0 + (PB) * (SEQ_BUF / 2); \
        const size_t row0 = rowb + (size_t)(c) * 64; \
        _Pragma("unroll") for (int p = 0; p < 2; ++p) { const int e = tid + 512 * p; \
            if (e < 64 * K8) { const int t = e / K8, k8 = (e % K8) * 8; *(LAS u32x4*)(QT + t * KP + k8) = R.qw[p]; \
                const unsigned kk[4] = {R.kw[p].x, R.kw[p].y, R.kw[p].z, R.kw[p].w}; \
                _Pragma("unroll") for (int i = 0; i < 8; ++i) KTT[(k8 + i) * 72 + tsw(k8 + i, t)] = (bf16_t)((i & 1) ? (kk[i >> 1] >> 16) : (kk[i >> 1] & 0xffffu)); } } \
        if (tid < 256) { const int t = tid >> 2, v8 = (tid & 3) * 8; const unsigned vv[4] = {R.vw.x, R.vw.y, R.vw.z, R.vw.w}; \
            _Pragma("unroll") for (int i = 0; i < 8; ++i) VT[(v8 + i) * 72 + tsw(v8 + i, t)] = (bf16_t)((i & 1) ? (vv[i >> 1] >> 16) : (vv[i >> 1] & 0xffffu)); } \
        if (wid < NKT) { \
            _Pragma("unroll") for (int v2 = 0; v2 < 2; ++v2) { const int k0 = wid * 16 + q * 4; u32x2 w; w.x = pk2(Sacc[v2][0] * R.fe[0], Sacc[v2][1] * R.fe[1]); w.y = pk2(Sacc[v2][2] * R.fe[2], Sacc[v2][3] * R.fe[3]); \
                *(LAS u32x2*)(ST + (v2 * 16 + r) * KP + k0) = w; } } \
        const f32x4 cfd = R.fd, cfc = R.fc; const u32x2 coi = R.oi; \
        bar_l(); \
        if ((c) + 2 < SEQ / 64) SEQ_LOAD(R, (c) + 2); \
        { f32x4 o; o[0] = bf_lo(coi.x); o[1] = bf_hi(coi.x); o[2] = bf_lo(coi.y); o[3] = bf_hi(coi.y); \
          _Pragma("unroll") for (int s = 0; s < NST; ++s) { const bf16x8 sf = *(const LAS bf16x8*)(ST + (vt * 16 + r) * KP + 32 * s + 8 * q); const bf16x8 qf = *(const LAS bf16x8*)(QT + (it * 16 + r) * KP + 32 * s + 8 * q); \
              o = MFMA16(sf, qf, o); } \
          u32x2 w; w.x = pk2(o[0], o[1]); w.y = pk2(o[2], o[3]); \
          *(u32x2*)(mix + (row0 + it * 16 + r) * 1024 + h * V + vs * 32 + vt * 16 + 4 * q) = w; } \
        if (wid < NKT) { \
            _Pragma("unroll") for (int v2 = 0; v2 < 2; ++v2) { f32x4 d = (f32x4){0.f, 0.f, 0.f, 0.f}; \
                _Pragma("unroll") for (int s = 0; s < 2; ++s) { const int kr = wid * 16 + r, vr = v2 * 16 + r; \
                    const bf16x8 kf = *(const LAS bf16x8*)(KTT + kr * 72 + tsw(kr, 32 * s + 8 * q)); const bf16x8 vf = *(const LAS bf16x8*)(VT + vr * 72 + tsw(vr, 32 * s + 8 * q)); \
                    d = MFMA16(kf, vf, d); } \
                _Pragma("unroll") for (int ii = 0; ii < 4; ++ii) Sacc[v2][ii] = cfd[ii] * Sacc[v2][ii] + cfc[ii] * d[ii]; } \
        } } while (0)
    bar();
    SEQ_LOAD(A, 0); SEQ_LOAD(B, 1);
    for (int c = 0; c < SEQ / 64; c += 2) { SEQ_BODY(A, c, 0); SEQ_BODY(B, c + 1, 1); }
#undef SEQ_LOAD
#undef SEQ_BODY
}


DI void ssd_pre(AP a, LAS unsigned char* lds, int item, const bf16_t* proj, bf16_t* mix, bf16_t* cbg, bf16_t* xdt, float* acsg) {
    constexpr int LDP = NPAD2, KP = 136;
    const int tid = TID(), lane = tid & 63, wid = tid >> 6, r = lane & 15, q = lane >> 4;
    const int c = item & 127, g = (item >> 7) & 1, b = item >> 8;
    constexpr int B_RAW = 0, B_CW = 67 * 640 * 2, B_CB = B_CW + 4 * 640 * 4, B_QT = B_CB + 640 * 4, B_KT = B_QT + 64 * KP * 2, B_VT = B_KT + 64 * KP * 2,
                  B_ATT = B_VT + 64 * 72 * 2, B_ACS = B_ATT + 64 * 72 * 2, B_DTS = B_ACS + 6 * 64 * 4, B_END = B_DTS + 6 * 64 * 4;
    static_assert(B_END <= LDS_BYTES - 32, "ssd_pre LDS");
    LAS bf16_t* RAW = (LAS bf16_t*)(lds + B_RAW); LAS float* CW = (LAS float*)(lds + B_CW); LAS float* CBs = (LAS float*)(lds + B_CB);
    LAS bf16_t* QT = (LAS bf16_t*)(lds + B_QT); LAS bf16_t* KT = (LAS bf16_t*)(lds + B_KT); LAS bf16_t* VT = (LAS bf16_t*)(lds + B_VT); LAS bf16_t* ATT = (LAS bf16_t*)(lds + B_ATT);
    LAS float* ACS = (LAS float*)(lds + B_ACS); LAS float* DTS = (LAS float*)(lds + B_DTS);
    const size_t rowb = (size_t)b * SEQ, row0 = rowb + (size_t)c * 64;
    bar();
    { const float* cw = a->in[23]; const float* cb = a->in[24];
      for (int i = tid; i < 640; i += 512) { const int ch = i < 384 ? g * 384 + i : (i < 512 ? 768 + g * 128 + (i - 384) : 1024 + g * 128 + (i - 512));
#pragma unroll
          for (int j = 0; j < 4; ++j) CW[j * 640 + i] = cw[j * 1280 + ch];
          CBs[i] = cb[ch]; } }
    for (int e = tid; e < 67 * 80; e += 512) { const int rw = e / 80, cv = e % 80; const long t = (long)c * 64 + rw - 3;
        const int col = cv < 48 ? 768 + g * 384 + cv * 8 : (cv < 64 ? 1536 + g * 128 + (cv - 48) * 8 : 1792 + g * 128 + (cv - 64) * 8);
        u32x4 w = (u32x4){0u, 0u, 0u, 0u}; if (t >= 0) w = *(const u32x4*)(proj + (rowb + t) * LDP + col);
        *(LAS u32x4*)(RAW + rw * 640 + cv * 8) = w; }
    if (wid < 6) { const int head = g * 6 + wid; const float dr = bf2f(proj[(row0 + lane) * LDP + 2304 + head]) + a->in[25][head]; const float dt = dr > 20.f ? dr : __logf(1.0f + __expf(dr));
        float cs = dt * (-__expf(a->in[26][head]));
#pragma unroll
        for (int o = 1; o < 64; o <<= 1) { const float n = __shfl_up(cs, o); if (lane >= o) cs += n; }
        ACS[wid * 64 + lane] = cs; DTS[wid * 64 + lane] = dt; acsg[(row0 + lane) * 12 + head] = cs; }
    bar();
    for (int e = tid; e < 64 * 32; e += 512) { const int t = e >> 5, cv = 48 + (e & 31); float val[8];
#pragma unroll
        for (int i = 0; i < 8; ++i) val[i] = CBs[cv * 8 + i];
#pragma unroll
        for (int j = 0; j < 4; ++j) { float f[8]; unpack8(*(const LAS u32x4*)(RAW + (t + j) * 640 + cv * 8), f);
#pragma unroll
            for (int i = 0; i < 8; ++i) val[i] += CW[j * 640 + cv * 8 + i] * f[i]; }
#pragma unroll
        for (int i = 0; i < 8; ++i) val[i] = siluf_(val[i]);
        const u32x4 w = pack8(val);
        if (cv < 64) { const int k8 = (cv - 48) * 8; *(LAS u32x4*)(KT + t * KP + k8) = w; *(u32x4*)(cbg + (row0 + t) * 512 + g * 256 + 128 + k8) = w; }
        else { const int k8 = (cv - 64) * 8; *(LAS u32x4*)(QT + t * KP + k8) = w; *(u32x4*)(cbg + (row0 + t) * 512 + g * 256 + k8) = w; } }
    bar();
    const int it = wid >> 1;
    f32x4 cbt[2];
#pragma unroll
    for (int jj = 0; jj < 2; ++jj) { const int jt = 2 * (wid & 1) + jj; cbt[jj] = (f32x4){0.f, 0.f, 0.f, 0.f};
#pragma unroll
        for (int s = 0; s < 4; ++s) { const bf16x8 kf = *(const LAS bf16x8*)(KT + (jt * 16 + r) * KP + 32 * s + 8 * q); const bf16x8 qf = *(const LAS bf16x8*)(QT + (it * 16 + r) * KP + 32 * s + 8 * q);
            cbt[jj] = MFMA16(kf, qf, cbt[jj]); } }
    for (int hh = 0; hh < 6; ++hh) {
        const int head = g * 6 + hh;
        const float Dh = a->in[27][head];
        bar();
        { const int t = tid >> 3, p8 = (tid & 7) * 8, cv = hh * 8 + (tid & 7); float val[8];
#pragma unroll
          for (int i = 0; i < 8; ++i) val[i] = CBs[cv * 8 + i];
#pragma unroll
          for (int j = 0; j < 4; ++j) { float f[8]; unpack8(*(const LAS u32x4*)(RAW + (t + j) * 640 + cv * 8), f);
#pragma unroll
              for (int i = 0; i < 8; ++i) val[i] += CW[j * 640 + cv * 8 + i] * f[i]; }
          const float dt = DTS[hh * 64 + t];
#pragma unroll
          for (int i = 0; i < 8; ++i) val[i] = siluf_(val[i]) * dt;
          const u32x4 w = pack8(val);
          *(u32x4*)(xdt + (row0 + t) * 768 + head * 64 + p8) = w;
          const unsigned vv[4] = {w.x, w.y, w.z, w.w};
#pragma unroll
          for (int i = 0; i < 8; ++i) VT[(p8 + i) * 72 + tsw(p8 + i, t)] = (bf16_t)((i & 1) ? (vv[i >> 1] >> 16) : (vv[i >> 1] & 0xffffu)); }
        { const int i = it * 16 + r; const float ai = ACS[hh * 64 + i];
#pragma unroll
          for (int jj = 0; jj < 2; ++jj) { const int jt = 2 * (wid & 1) + jj; float v4[4];
#pragma unroll
              for (int ii = 0; ii < 4; ++ii) { const int j = jt * 16 + 4 * q + ii; float v = (j <= i) ? cbt[jj][ii] * __expf(ai - ACS[hh * 64 + j]) : 0.f;
                  if (j == i) v += Dh * __builtin_amdgcn_rcpf(DTS[hh * 64 + i]);
                  v4[ii] = v; }
              u32x2 w; w.x = pk2(v4[0], v4[1]); w.y = pk2(v4[2], v4[3]); *(LAS u32x2*)(ATT + i * 72 + jt * 16 + 4 * q) = w; } }
        bar();
#pragma unroll
        for (int j = 0; j < 2; ++j) { const int vt = (wid & 1) + 2 * j; f32x4 o = (f32x4){0.f, 0.f, 0.f, 0.f};
#pragma unroll
            for (int s = 0; s < 2; ++s) { const int vr = vt * 16 + r; const bf16x8 vf = *(const LAS bf16x8*)(VT + vr * 72 + tsw(vr, 32 * s + 8 * q)); const bf16x8 af = *(const LAS bf16x8*)(ATT + (it * 16 + r) * 72 + 32 * s + 8 * q);
                o = MFMA16(vf, af, o); }
            u32x2 w; w.x = pk2(o[0], o[1]); w.y = pk2(o[2], o[3]);
            *(u32x2*)(mix + (row0 + it * 16 + r) * 1024 + head * 64 + vt * 16 + 4 * q) = w; }
    }
}

DI void ssd_seq(AP a, LAS unsigned char* lds, int unit, const bf16_t* proj, bf16_t* mix, const bf16_t* cbg, const bf16_t* xdt, const float* acsg) {
    constexpr int K = 128, KP = 136, LDP = NPAD2;
    const int tid = TID(), lane = tid & 63, wid = tid >> 6, r = lane & 15, q = lane >> 4;
    const int vs = unit & 1, head = (unit >> 1) % 12, b = unit / 24, g = head / 6;
    constexpr int B_QT = 0, B_KTT = B_QT + 64 * KP * 2, B_VT = B_KTT + K * 72 * 2, B_ST = B_VT + 32 * 72 * 2;
    constexpr int SEQ_BUF = B_ST + 32 * KP * 2;
    LAS bf16_t* QT0 = (LAS bf16_t*)(lds + B_QT); LAS bf16_t* KTT0 = (LAS bf16_t*)(lds + B_KTT); LAS bf16_t* VT0 = (LAS bf16_t*)(lds + B_VT); LAS bf16_t* ST0 = (LAS bf16_t*)(lds + B_ST);
    const size_t rowb = (size_t)b * SEQ;
    const int it = wid >> 1, vt = wid & 1;
    f32x4 Sacc[2]; Sacc[0] = (f32x4){0.f, 0.f, 0.f, 0.f}; Sacc[1] = Sacc[0];
    struct RS { u32x4 qw[2], kw[2], vw; u32x2 oi, zw; float a0, a1, al; };
    RS A, B;
#define SSD_LOAD(R, cc) do { const size_t row0_ = rowb + (size_t)(cc) * 64; \
        _Pragma("unroll") for (int p = 0; p < 2; ++p) { const int e = tid + 512 * p; const int t = e >> 4, k8 = (e & 15) * 8; const bf16_t* rp = cbg + (row0_ + t) * 512 + g * 256 + k8; R.qw[p] = *(const u32x4*)rp; R.kw[p] = *(const u32x4*)(rp + 128); } \
        R.vw = (u32x4){0u, 0u, 0u, 0u}; if (tid < 256) R.vw = *(const u32x4*)(xdt + (row0_ + (tid >> 2)) * 768 + head * 64 + vs * 32 + (tid & 3) * 8); \
        R.oi = *(const u32x2*)(mix + (row0_ + it * 16 + r) * 1024 + head * 64 + vs * 32 + vt * 16 + 4 * q); \
        R.zw = *(const u32x2*)(proj + (row0_ + it * 16 + r) * LDP + head * 64 + vs * 32 + vt * 16 + 4 * q); \
        R.a0 = acsg[(row0_ + (tid >> 4)) * 12 + head]; R.a1 = acsg[(row0_ + 32 + (tid >> 4)) * 12 + head]; R.al = acsg[(row0_ + 63) * 12 + head]; } while (0)
#define SSD_BODY(R, c, PB) do { \
        LAS bf16_t* QT = QT0 + (PB) * (SEQ_BUF / 2); LAS bf16_t* KTT = KTT0 + (PB) * (SEQ_BUF / 2); LAS bf16_t* VT = VT0 + (PB) * (SEQ_BUF / 2); LAS bf16_t* ST = ST0 + (PB) * (SEQ_BUF / 2); \
        const size_t row0 = rowb + (size_t)(c) * 64; \
        _Pragma("unroll") for (int p = 0; p < 2; ++p) { const int e = tid + 512 * p; const int t = e >> 4, k8 = (e & 15) * 8; const float at = p == 0 ? R.a0 : R.a1; \
            const float e1 = __expf(at), e2 = __expf(R.al - at); float cf[8], bfv[8]; unpack8(R.qw[p], cf); unpack8(R.kw[p], bfv); \
            _Pragma("unroll") for (int i = 0; i < 8; ++i) { cf[i] *= e1; bfv[i] *= e2; } \
            *(LAS u32x4*)(QT + t * KP + k8) = pack8(cf); const u32x4 kp = pack8(bfv); const unsigned kk[4] = {kp.x, kp.y, kp.z, kp.w}; \
            _Pragma("unroll") for (int i = 0; i < 8; ++i) KTT[(k8 + i) * 72 + tsw(k8 + i, t)] = (bf16_t)((i & 1) ? (kk[i >> 1] >> 16) : (kk[i >> 1] & 0xffffu)); } \
        if (tid < 256) { const int t = tid >> 2, v8 = (tid & 3) * 8; const unsigned vv[4] = {R.vw.x, R.vw.y, R.vw.z, R.vw.w}; \
            _Pragma("unroll") for (int i = 0; i < 8; ++i) VT[(v8 + i) * 72 + tsw(v8 + i, t)] = (bf16_t)((i & 1) ? (vv[i >> 1] >> 16) : (vv[i >> 1] & 0xffffu)); } \
        _Pragma("unroll") for (int v2 = 0; v2 < 2; ++v2) { const int k0 = wid * 16 + q * 4; u32x2 w; w.x = pk2(Sacc[v2][0], Sacc[v2][1]); w.y = pk2(Sacc[v2][2], Sacc[v2][3]); \
            *(LAS u32x2*)(ST + (v2 * 16 + r) * KP + k0) = w; } \
        const float dec = __expf(R.al); const u32x2 coi = R.oi, czw = R.zw; \
        bar_l(); \
        if ((c) + 2 < SEQ / 64) SSD_LOAD(R, (c) + 2); \
        { f32x4 o; o[0] = bf_lo(coi.x); o[1] = bf_hi(coi.x); o[2] = bf_lo(coi.y); o[3] = bf_hi(coi.y); \
          _Pragma("unroll") for (int s = 0; s < 4; ++s) { const bf16x8 sf = *(const LAS bf16x8*)(ST + (vt * 16 + r) * KP + 32 * s + 8 * q); const bf16x8 qf = *(const LAS bf16x8*)(QT + (it * 16 + r) * KP + 32 * s + 8 * q); \
              o = MFMA16(sf, qf, o); } \
          o[0] *= siluf_(bf_lo(czw.x)); o[1] *= siluf_(bf_hi(czw.x)); o[2] *= siluf_(bf_lo(czw.y)); o[3] *= siluf_(bf_hi(czw.y)); \
          u32x2 w; w.x = pk2(o[0], o[1]); w.y = pk2(o[2], o[3]); \
          *(u32x2*)(mix + (row0 + it * 16 + r) * 1024 + head * 64 + vs * 32 + vt * 16 + 4 * q) = w; } \
        _Pragma("unroll") for (int v2 = 0; v2 < 2; ++v2) { f32x4 d = (f32x4){0.f, 0.f, 0.f, 0.f}; \
            _Pragma("unroll") for (int s = 0; s < 2; ++s) { const int kr = wid * 16 + r, vr = v2 * 16 + r; \
                const bf16x8 kf = *(const LAS bf16x8*)(KTT + kr * 72 + tsw(kr, 32 * s + 8 * q)); const bf16x8 vf = *(const LAS bf16x8*)(VT + vr * 72 + tsw(vr, 32 * s + 8 * q)); \
                d = MFMA16(kf, vf, d); } \
            _Pragma("unroll") for (int ii = 0; ii < 4; ++ii) Sacc[v2][ii] = dec * Sacc[v2][ii] + d[ii]; } } while (0)
    bar();
    SSD_LOAD(A, 0); SSD_LOAD(B, 1);
    for (int c = 0; c < SEQ / 64; c += 2) { SSD_BODY(A, c, 0); SSD_BODY(B, c + 1, 1); }
#undef SSD_LOAD
#undef SSD_BODY
}

DI void post_pass(AP a, int layer, const bf16_t* proj, bf16_t* mix) {
    const int lane = TID() & 63, wid = TID() >> 6;
    for (int row = BID() * 8 + wid; row < NTOK; row += GDIM() * 8) {
        if (layer == 1) {
            if (((row - BID() * 8 - wid) / (GDIM() * 8)) & 1) continue;
            const float* lse = (const float*)(a->ws + O_LSE);
            const int hh = lane >> 4, d8 = (lane & 15) * 8;
            u32x4 v[2][3]; float lv[2][3]; int rows[2]; bool ok[2];
#pragma unroll
            for (int u = 0; u < 2; ++u) { rows[u] = row + u * GDIM() * 8; ok[u] = rows[u] < NTOK; const int ru = ok[u] ? rows[u] : row;
#pragma unroll
                for (int g = 0; g < 3; ++g) { lv[u][g] = lse[((size_t)g * NTOK + ru) * 4 + hh]; v[u][g] = *(const u32x4*)(proj + (size_t)ru * 4864 + (g * 4 + hh) * 128 + d8); } }
#pragma unroll
            for (int u = 0; u < 2; ++u) {
                if (!ok[u]) continue;
                const float m = fmaxf(lv[u][0], fmaxf(lv[u][1], lv[u][2])); const float e0 = __expf(lv[u][0] - m), e1 = __expf(lv[u][1] - m), e2 = __expf(lv[u][2] - m); const float inv = 1.0f / (e0 + e1 + e2);
                const float w[3] = {e0 * inv, e1 * inv, e2 * inv};
                float o[8] = {0.f, 0.f, 0.f, 0.f, 0.f, 0.f, 0.f, 0.f};
#pragma unroll
                for (int g = 0; g < 3; ++g) { float f[8]; unpack8(v[u][g], f);
#pragma unroll
                    for (int i = 0; i < 8; ++i) o[i] += w[g] * f[i]; }
                *(u32x4*)(mix + (size_t)rows[u] * 768 + hh * 128 + d8) = pack8(o);
            }
        } else {
            if (((row - BID() * 8 - wid) / (GDIM() * 8)) & 1) continue;
            u32x4 mw[2][2], gw[2][2]; int rows[2]; bool ok[2];
#pragma unroll
            for (int u = 0; u < 2; ++u) { rows[u] = row + u * GDIM() * 8; ok[u] = rows[u] < NTOK; const int ru = ok[u] ? rows[u] : row;
                const bf16_t* mp = mix + (size_t)ru * 1024;
                mw[u][0] = *(const u32x4*)(mp + lane * 8); mw[u][1] = (u32x4){0u, 0u, 0u, 0u}; gw[u][0] = mw[u][1]; gw[u][1] = mw[u][1];
                if (lane < 32) mw[u][1] = *(const u32x4*)(mp + (lane + 64) * 8);
                if (layer != 2) { const bf16_t* gp = layer == 0 ? proj + (size_t)ru * NPAD0 + 1552 : proj + (size_t)ru * NPAD3 + 2304;
                    gw[u][0] = *(const u32x4*)(gp + lane * 8); if (lane < 32) gw[u][1] = *(const u32x4*)(gp + (lane + 64) * 8); } }
            const int GW = layer == 0 ? 24 : (layer == 2 ? 48 : 16);
            const int NG = 96 / GW;
            const int g0 = lane / GW, g1 = (lane + 64) / GW;
#pragma unroll
            for (int u = 0; u < 2; ++u) {
                if (!ok[u]) continue;
                float f0[8], f1[8]; unpack8(mw[u][0], f0); unpack8(mw[u][1], f1);
                float q0 = 0.f, q1 = 0.f;
#pragma unroll
                for (int i = 0; i < 8; ++i) { q0 += f0[i] * f0[i]; q1 += f1[i] * f1[i]; }
                float sc0 = 0.f, sc1 = 0.f;
                for (int g = 0; g < NG; ++g) {
                    const float t = wave_sum((g0 == g ? q0 : 0.f) + ((lane < 32 && g1 == g) ? q1 : 0.f));
                    const float sc = rsqrtf(t / (float)(GW * 8) + EPS);
                    if (g0 == g) sc0 = sc; if (g1 == g) sc1 = sc;
                }
                bf16_t* mp = mix + (size_t)rows[u] * 1024;
#pragma unroll
                for (int p = 0; p < 2; ++p) {
                    if (p == 1 && lane >= 32) break;
                    const int c8 = (p == 0 ? lane : lane + 64) * 8; const float sc = p == 0 ? sc0 : sc1; float* f = p == 0 ? f0 : f1;
                    float g[8]; unpack8(gw[u][p], g);
                    if (layer == 0) {
#pragma unroll
                        for (int i = 0; i < 8; ++i) f[i] = f[i] * sc * a->in[16][(c8 + i) % 192] * siluf_(g[i]); }
                    else if (layer == 2) {
#pragma unroll
                        for (int i = 0; i < 8; ++i) f[i] = f[i] * sc * a->in[28][c8 + i]; }
                    else {
#pragma unroll
                        for (int i = 0; i < 8; ++i) f[i] = f[i] * sc * a->in[32][(c8 + i) % 128] * sigmoidf_(g[i]); }
                    *(u32x4*)(mp + c8) = pack8(f);
                }
            }
        }
    }
}

DI void act_pass(AP a, int layer, int half) {
    const bf16_t* U = (const bf16_t*)(a->ws + O_BIG); bf16_t* ACT = (bf16_t*)(a->ws + O_ACTB);
    const float* cw = a->in[10] + (size_t)layer * 3 * 5632; const float* cb = a->in[11] + (size_t)layer * 5632;
    const size_t nitem = (size_t)(32768 / 32) * 352;
    for (size_t it = (size_t)BID() * 512 + TID(); it < nitem; it += (size_t)GDIM() * 512) {
        const int cg8 = (int)(it % 352) * 8, run = 1023 - (int)(it / 352); const int r0 = run * 32;
        float wg[3][8], wv[3][8], bgv[8], bvv[8];
#pragma unroll
        for (int i = 0; i < 8; ++i) { bgv[i] = cb[cg8 + i]; bvv[i] = cb[2816 + cg8 + i];
#pragma unroll
            for (int j = 0; j < 3; ++j) { wg[j][i] = cw[j * 5632 + cg8 + i]; wv[j][i] = cw[j * 5632 + 2816 + cg8 + i]; } }
        float g1[8], g2[8], v1[8], v2[8];
        const bool first = (r0 % SEQ) == 0;
        if (first) {
#pragma unroll
            for (int i = 0; i < 8; ++i) { g1[i] = g2[i] = v1[i] = v2[i] = 0.f; }
        } else {
            unpack8(*(const u32x4*)(U + (size_t)(r0 - 1) * 5632 + cg8), g1); unpack8(*(const u32x4*)(U + (size_t)(r0 - 2) * 5632 + cg8), g2);
            unpack8(*(const u32x4*)(U + (size_t)(r0 - 1) * 5632 + 2816 + cg8), v1); unpack8(*(const u32x4*)(U + (size_t)(r0 - 2) * 5632 + 2816 + cg8), v2);
        }
        for (int tb = 0; tb < 32; tb += 8) {
            u32x4 gw[8], vw8[8];
#pragma unroll
            for (int u = 0; u < 8; ++u) { gw[u] = *(const u32x4*)(U + (size_t)(r0 + tb + u) * 5632 + cg8); vw8[u] = *(const u32x4*)(U + (size_t)(r0 + tb + u) * 5632 + 2816 + cg8); }
#pragma unroll
            for (int u = 0; u < 8; ++u) {
                float g0[8], v0[8], o[8];
                unpack8(gw[u], g0); unpack8(vw8[u], v0);
#pragma unroll
                for (int i = 0; i < 8; ++i) { const float gg = bgv[i] + wg[0][i] * g2[i] + wg[1][i] * g1[i] + wg[2][i] * g0[i]; const float vv = bvv[i] + wv[0][i] * v2[i] + wv[1][i] * v1[i] + wv[2][i] * v0[i];
                    o[i] = siluf_(gg) * vv; g2[i] = g1[i]; g1[i] = g0[i]; v2[i] = v1[i]; v1[i] = v0[i]; }
                *(u32x4*)(ACT + (size_t)(r0 + tb + u) * 2816 + cg8) = pack8(o);
            }
        }
    }
    (void)half;
}


#define XB_TMO      128
#define XB_XCNT(j)  (256  + 64 * (j))
#define XB_XSUB(j)  (1280 + 64 * (j))
#define XB_XGEN(j)  (2304 + 64 * (j))
#define XB_TOP      3328
#define XB_TOPGEN   3392
#define XCD_BAR_WORDS 3456
#define XB_SPIN_CAP (1u << 18)
DI unsigned xb_ld(unsigned* p)              { return __hip_atomic_load(p, __ATOMIC_RELAXED, __HIP_MEMORY_SCOPE_AGENT); }
DI unsigned xb_add(unsigned* p, unsigned v) { return __hip_atomic_fetch_add(p, v, __ATOMIC_RELAXED, __HIP_MEMORY_SCOPE_AGENT); }
DI unsigned xb_xcc_id() { return (unsigned)__builtin_amdgcn_s_getreg((3 << 11) | 20) & 0xFu; }
#define XB_SPIN(cond, bar) do { unsigned _sp = 0; while (cond) { __builtin_amdgcn_s_sleep(1); \
    if ((++_sp & 255u) == 0u) { if (xb_ld(&(bar)[XB_TMO])) break; if (_sp > XB_SPIN_CAP) { atomicAdd(&(bar)[XB_TMO], 1u); break; } } } } while (0)
DI void xcd_barrier_complete(unsigned* bar, unsigned x, unsigned& nloc, unsigned& nx) {
    const unsigned G = gridDim.x;
    unsigned sum, cnt, mine, sp = 0u;
    for (;;) {
        sum = 0u; cnt = 0u; mine = 0u;
#pragma unroll
        for (unsigned j = 0; j < 16; ++j) { const unsigned c = xb_ld(&bar[XB_XCNT(j)]); sum += c; cnt += (c > 0u) ? 1u : 0u; mine = (j == x) ? c : mine; }
        if (sum == G) break;
        __builtin_amdgcn_s_sleep(1);
        if ((++sp & 255u) == 0u) { if (xb_ld(&bar[XB_TMO])) break; if (sp > XB_SPIN_CAP) { atomicAdd(&bar[XB_TMO], 1u); break; } }
    }
    nloc = mine > 0u ? mine : 1u; nx = cnt > 0u ? cnt : 1u;
}
DI void xcd_barrier(unsigned* bar, volatile LAS unsigned* st) {
    asm volatile("s_waitcnt vmcnt(0)" ::: "memory");
    __syncthreads();
    if (threadIdx.x == 0) {
        const unsigned x = xb_xcc_id();
        __builtin_amdgcn_s_waitcnt(0);
        unsigned nloc = st[0], nx = st[1];
        if (nloc == 0u) { xcd_barrier_complete(bar, x, nloc, nx); st[0] = nloc; st[1] = nx; }
        const unsigned old = xb_add(&bar[XB_XSUB(x)], 1u);
        const unsigned gen = old / nloc;
        if (old + 1u == (gen + 1u) * nloc) {
            __builtin_amdgcn_fence(__ATOMIC_RELEASE, "agent");
            asm volatile("s_waitcnt vmcnt(0)" ::: "memory");
            const unsigned og = xb_add(&bar[XB_TOP], 1u);
            const unsigned tg = og / nx;
            if (og + 1u == (tg + 1u) * nx) xb_add(&bar[XB_TOPGEN], 1u);
            else XB_SPIN(xb_ld(&bar[XB_TOPGEN]) == tg, bar);
            __builtin_amdgcn_fence(__ATOMIC_ACQUIRE, "agent");
            xb_add(&bar[XB_XGEN(x)], 1u);
            asm volatile("s_waitcnt vmcnt(0)" ::: "memory");
        } else {
            XB_SPIN(xb_ld(&bar[XB_XGEN(x)]) == gen, bar);
            __builtin_amdgcn_fence(__ATOMIC_ACQUIRE, "agent");
            asm volatile("s_waitcnt vmcnt(0)" ::: "memory");
        }
    }
    __syncthreads();
}

#ifndef EN
#define EN 1023
#endif
#ifndef EN2
#define EN2 3
#endif
constexpr int NPHASE = 2 + 4 * 10;
__global__ void __launch_bounds__(512) fwd_kernel(Args karg) {
    __shared__ __attribute__((aligned(16))) unsigned char smem[LDS_BYTES];
    LAS unsigned char* lds = (LAS unsigned char*)smem;
    const int ph_lo = karg.ph_lo, ph_hi = karg.ph_hi;
    { volatile LAS unsigned* st0 = (volatile LAS unsigned*)(lds + LDS_BYTES - 32); if (threadIdx.x < 2) st0[threadIdx.x] = 0u; __syncthreads();
      if (threadIdx.x == 0) (void)xb_add(&((unsigned*)(karg.ws + O_XBAR))[XB_XCNT(xb_xcc_id())], 1u); }
#ifdef DIAG_ZERO
    for (int i = threadIdx.x; i < LDS_BYTES / 4; i += 512) ((LAS unsigned*)lds)[i] = 0u;
    __syncthreads();
#endif
    for (int ph = ph_lo; ph < ph_hi; ++ph) {
        AP a = (AP)__builtin_amdgcn_kernarg_segment_ptr(); asm volatile("" : "+s"(a));
        unsigned char* ws = a->ws;
        const int tid = TID();
        pg8::Gemm gs{}, gr{}; pg8::EpiScale es{}; pg8::EpiResid er{}; bool dos = false, dor = false, skip = false;
        bf16_t* XB = (bf16_t*)(ws + O_XB); float* SSp = (float*)(ws + O_SS);
        if (ph == 0) { for (int rep_ = 0; rep_ < DUP_P; ++rep_) prologue(a, lds); }
        else if (ph == 1) { gs.A = (const bf16_t*)(ws + O_MEMN); gs.Bt = (const bf16_t*)(ws + O_WKV); gs.M = 2048; gs.N = 2048; gs.K = 1024; es.O = (bf16_t*)(ws + O_KVM); es.ldc = 2048; es.ss = nullptr; dos = true; }
        else {
            const int l = (ph - 2) / 10, s = (ph - 2) % 10;
            const int np = l == 0 ? NPAD0 : (l == 1 ? NPAD1 : (l == 2 ? NPAD2 : NPAD3));
            bf16_t* proj = (bf16_t*)(ws + O_BIG); bf16_t* mix = proj + (size_t)NTOK * np;
            const int kout = l == 1 ? 768 : 1024;
            const size_t owin = l == 0 ? O_WIN0 : (l == 1 ? O_WIN1 : (l == 2 ? O_WIN2 : O_WIN3)), owout = l == 0 ? O_WOUT0 : (l == 1 ? O_WOUT1 : (l == 2 ? O_WOUT2 : O_WOUT3));
            unsigned* ctr = (unsigned*)(ws + O_CTR) + l * 64;
            LAS unsigned* bc = (LAS unsigned*)(lds + LDS_BYTES - 16);
            float* fac = (float*)(ws + O_FAC);
            bf16_t* cbg = (bf16_t*)(ws + O_BIG + (size_t)469762048); bf16_t* xdtb = (bf16_t*)(ws + O_BIG + (size_t)536870912); float* acsg = (float*)(ws + O_BIG + (size_t)637534208);
            const int xqcol = l == 0 ? 2320 : (l == 1 ? 4608 : (l == 2 ? 2048 : 3072));
            if (s == 2 && l == 1) skip = true;
            else if (s == 0) { gs.A = XB; gs.Bt = (const bf16_t*)(ws + owin); gs.M = NTOK; gs.N = np; gs.K = 1024; es.O = proj; es.ldc = np; es.ss = SSp + (size_t)((2 * l) % 3) * NTOK * 16; dos = true; }
            else if (s == 1) {
                if (l == 1) {
                    for (int t = BID(); t < 6144; t += GDIM()) dil_tile(a, lds, t, proj);
                } else if (l == 2) {
                    for (int rep_ = 0; rep_ < DUP_P; ++rep_) for (int itx = BID(); itx < 2048; itx += GDIM()) ssd_pre(a, lds, itx, proj, mix, cbg, xdtb, acsg);
                } else {
                    const int nitem = l == 0 ? 4096 : 6144;
                    for (int rep_ = 0; rep_ < DUP_PRE; ++rep_) for (int itx = BID(); itx < nitem; itx += GDIM()) { if (l == 0) scan_pre<0>(a, lds, itx, proj, mix, fac, rep_ == DUP_PRE - 1); else scan_pre<3>(a, lds, itx, proj, mix, fac, rep_ == DUP_PRE - 1); }
                }
                if (l == 1) { for (int t = BID(); t < 2048; t += GDIM()) xa_tile(a, lds, l, t, proj, np, xqcol, mix, kout, kout - 256); }
            }
            else if (s == 2) {
                for (int u = BID(); u < 192; u += GDIM()) { if (EN2 & 2) { if (l == 0) scan_seq<0>(a, lds, u, proj, mix, fac); else if (l == 2) ssd_seq(a, lds, u, proj, mix, cbg, xdtb, acsg); else scan_seq<3>(a, lds, u, proj, mix, fac); } }
                unsigned* ctr2 = ctr + 16;
                for (;;) { bar(); if (tid == 0) *bc = atomicAdd(ctr2, 1u); bar(); const unsigned t = *bc; if (t >= 2048u * DUP_XA) break; xa_tile(a, lds, l, (int)t, proj, np, xqcol, mix, kout, kout - 256); }
            }
            else if (s == 3) post_pass(a, l, proj, mix);
            else if (s == 4) { gr.A = mix; gr.Bt = (const bf16_t*)(ws + owout); gr.M = NTOK; gr.N = 1024; gr.K = kout; er.xb = XB; er.fout = nullptr; er.ssn = SSp + (size_t)((2 * l + 1) % 3) * NTOK * 16; dor = true; }
            else if (s == 6 || s == 8) act_pass(a, l, s == 6 ? 0 : 1);
            else {
                if (s == 5 || s == 7) { const int hf = s == 5 ? 0 : 1; gs.A = XB + (size_t)hf * 32768 * 1024; gs.Bt = (const bf16_t*)(ws + O_WUP) + (size_t)l * 5632 * 1024; gs.M = 32768; gs.N = 5632; gs.K = 1024;
                    es.O = (bf16_t*)(ws + O_BIG); es.ldc = 5632; es.ss = SSp + ((size_t)((2 * l + 1) % 3) * NTOK + (size_t)hf * 32768) * 16; dos = true; }
                if (s == 7 || s == 9) { const int hf = s == 7 ? 0 : 1; const size_t ro = (size_t)hf * 32768; gr.A = (const bf16_t*)(ws + O_ACTB); gr.Bt = (const bf16_t*)(ws + O_WDN) + (size_t)l * 1024 * 2816; gr.M = 32768; gr.N = 1024; gr.K = 2816;
                    er.xb = XB + ro * 1024; er.fout = l == 3 ? a->out + ro * 1024 : nullptr; er.ssn = l == 3 ? nullptr : SSp + ((size_t)((2 * l + 2) % 3) * NTOK + ro) * 16; dor = true; }
            }
        }
        if (dor && (EN & 256)) { pg8::StaticOrder S; S.init(gr.M, gr.N, GDIM(), BID()); pg8::gemm_phase<pg8::EpiResid>(lds, gr, S, er); }
        if (dos && (EN & 512)) { { pg8::StaticOrder S; S.init(gs.M, gs.N, GDIM(), BID()); pg8::gemm_phase<pg8::EpiScale>(lds, gs, S, es); } }
        if (!skip && ph + 1 < ph_hi) { if (ph_hi < 0) cg::this_grid().sync(); xcd_barrier((unsigned*)(a->ws + O_XBAR), (volatile LAS unsigned*)(lds + LDS_BYTES - 32)); }
    }
}

#ifndef NPH_RUN
#endif
#ifndef MK_SINGLE
#define MK_SINGLE 1
#endif
extern "C" void kernel_launch(void* const* d_in, const int* in_sizes, int n_in, void* d_out, int out_size, void* d_ws, size_t ws_size, hipStream_t stream) {
    static int grid = 0;
    if (grid == 0) {
        if (n_in != 34 || ws_size < WS_END) { fprintf(stderr, "kernel_launch: unexpected n_in %d / ws %zu (need %zu)\n", n_in, ws_size, (size_t)WS_END); grid = -1; return; }
        int dev = 0, cus = 0, per_cu = 0;
        (void)hipGetDevice(&dev); (void)hipDeviceGetAttribute(&cus, hipDeviceAttributeMultiprocessorCount, dev);
        (void)hipOccupancyMaxActiveBlocksPerMultiprocessor(&per_cu, (const void*)fwd_kernel, 512, 0);
        (void)hipGetLastError();
        if (per_cu < 1) per_cu = 1;
        grid = cus * per_cu;
    }
    if (grid < 0) return;
#ifdef DIAG_ZERO
    (void)hipMemsetAsync(d_ws, 0, WS_END, stream); (void)hipMemsetAsync(d_out, 0, (size_t)out_size * 4, stream);
#endif
    Args ha{};
    for (int i = 0; i < 34; ++i) ha.in[i] = (const float*)d_in[i];
    ha.out = (float*)d_out; ha.ws = (unsigned char*)d_ws;
#if MK_SINGLE
    (void)hipMemsetAsync((unsigned char*)d_ws + O_XBAR, 0, 16384, stream);
    ha.ph_lo = 0; ha.ph_hi = NPHASE;
    void* args[] = {&ha};
    hipError_t e = hipLaunchCooperativeKernel((const void*)fwd_kernel, dim3(grid), dim3(512), args, 0, stream);
    if (e != hipSuccess) fprintf(stderr, "cooperative launch failed: %s (grid %d)\n", hipGetErrorString(e), grid);
#else
    for (int ph = 0; ph < NPHASE; ++ph) {
        ha.ph_lo = ph; ha.ph_hi = ph + 1;
        hipLaunchKernelGGL(fwd_kernel, dim3(grid), dim3(512), 0, stream, ha);
    }
#endif
}
```

```cpp
#include <hip/hip_runtime.h>
#define DUP_XA 1
#define DUP_P 1
#define DUP_PRE 1
#define DUP_DIL 1

#include <hip/hip_cooperative_groups.h>
#include <cstdio>
namespace cg = cooperative_groups;

#define DI __device__ __forceinline__
#define LAS __attribute__((address_space(3)))
typedef unsigned short bf16_t;
typedef short bf16x8 __attribute__((ext_vector_type(8)));
typedef short s16x4 __attribute__((ext_vector_type(4)));
typedef float f32x4 __attribute__((ext_vector_type(4)));
typedef unsigned u32x4 __attribute__((ext_vector_type(4)));
typedef unsigned u32x2 __attribute__((ext_vector_type(2)));

constexpr int NTOK = 65536, SEQ = 8192, DM = 1024, DFF = 2816;
constexpr int LDS_BYTES = 163840;
constexpr float EPS = 1e-6f;

constexpr size_t al256(size_t x) { return (x + 255) & ~(size_t)255; }
constexpr int NPAD0 = 2816, NPAD1 = 4864, NPAD2 = 2560, NPAD3 = 3328;
constexpr size_t O_WIN0 = 0;
constexpr size_t O_WIN1 = O_WIN0 + (size_t)NPAD0 * 1024 * 2;
constexpr size_t O_WIN2 = O_WIN1 + (size_t)NPAD1 * 1024 * 2;
constexpr size_t O_WIN3 = O_WIN2 + (size_t)NPAD2 * 1024 * 2;
constexpr size_t O_WOUT0 = O_WIN3 + (size_t)NPAD3 * 1024 * 2;
constexpr size_t O_WOUT1 = O_WOUT0 + (size_t)1024 * 1024 * 2;
constexpr size_t O_WOUT2 = O_WOUT1 + (size_t)1024 * 768 * 2;
constexpr size_t O_WOUT3 = O_WOUT2 + (size_t)1024 * 1024 * 2;
constexpr size_t O_WUP = O_WOUT3 + (size_t)1024 * 1024 * 2;
constexpr size_t O_WDN = O_WUP + (size_t)4 * 5632 * 1024 * 2;
constexpr size_t O_WKV = O_WDN + (size_t)4 * 1024 * 2816 * 2;
constexpr size_t O_XB = O_WKV + (size_t)2048 * 1024 * 2;
constexpr size_t O_MEMN = O_XB + (size_t)NTOK * 1024 * 2;
constexpr size_t O_KVM = O_MEMN + (size_t)2048 * 1024 * 2;
constexpr size_t O_SS = O_KVM + (size_t)2048 * 2048 * 2;
constexpr size_t O_LSE = O_SS + (size_t)3 * NTOK * 16 * 4;
constexpr size_t O_ROPE = O_LSE + (size_t)3 * NTOK * 4 * 4;
constexpr size_t O_CTR = O_ROPE + (size_t)NTOK * 64 * 4;
constexpr size_t O_FAC = O_CTR + 4096;
constexpr size_t O_XBAR = O_FAC + (size_t)6144 * 3 * 128 * 4;
constexpr size_t O_BIG = O_XBAR + 16384;
constexpr size_t BIG_BYTES = (size_t)NTOK * (4864 + 768) * 2;
constexpr size_t WS_END = O_BIG + BIG_BYTES;
constexpr size_t O_ACTB = O_BIG + (size_t)32768 * 5632 * 2;

struct Args {
    const float* in[34];
    float* out;
    unsigned char* ws;
    int ph_lo, ph_hi;
};

typedef const __attribute__((address_space(4))) Args* AP;
DI int TID() { int t = threadIdx.x; asm volatile("" : "+v"(t)); return t; }
DI int BID() { int t = blockIdx.x; asm volatile("" : "+s"(t)); return t; }
DI int GDIM() { int t = gridDim.x; asm volatile("" : "+s"(t)); return t; }
DI float bf_lo(unsigned w) { return __uint_as_float(w << 16); }
DI float bf_hi(unsigned w) { return __uint_as_float(w & 0xffff0000u); }
DI float bf2f(bf16_t b) { return __uint_as_float(((unsigned)b) << 16); }
typedef float f32x2_t __attribute__((ext_vector_type(2)));
typedef __bf16 bf16x2_t __attribute__((ext_vector_type(2)));
DI unsigned pk2(float lo, float hi) { const f32x2_t v = {lo, hi}; const bf16x2_t b = __builtin_convertvector(v, bf16x2_t); return __builtin_bit_cast(unsigned, b); }
DI bf16_t f2bf(float f) { return (bf16_t)(pk2(f, f) & 0xffffu); }
DI void unpack8(const u32x4 w, float* f) {
    f[0] = bf_lo(w.x); f[1] = bf_hi(w.x); f[2] = bf_lo(w.y); f[3] = bf_hi(w.y);
    f[4] = bf_lo(w.z); f[5] = bf_hi(w.z); f[6] = bf_lo(w.w); f[7] = bf_hi(w.w);
}
DI u32x4 pack8(const float* f) { u32x4 w; w.x = pk2(f[0], f[1]); w.y = pk2(f[2], f[3]); w.z = pk2(f[4], f[5]); w.w = pk2(f[6], f[7]); return w; }
DI float sigmoidf_(float x) { return __builtin_amdgcn_rcpf(1.0f + __expf(-x)); }
DI float siluf_(float x) { return x * sigmoidf_(x); }
DI float wave_sum(float v) { for (int o = 32; o >= 1; o >>= 1) v += __shfl_xor(v, o); return v; }
#define MFMA16(a, b, c) __builtin_amdgcn_mfma_f32_16x16x32_bf16((a), (b), (c), 0, 0, 0)
DI void bar() { __syncthreads(); }
DI void bar_l() { asm volatile("s_waitcnt lgkmcnt(0)" ::: "memory"); __builtin_amdgcn_s_barrier(); asm volatile("" ::: "memory"); }

namespace pg8 {
constexpr int BM = 256, BK = 64, HALF = 128, HTB = HALF * BK * 2, STAGE_BYTES = 8 * HTB, NXCD = 8, WGM = 8;
DI int lds_byte(int r, int c) { const int st = (r >> 4) * 2 + (c >> 5), rr = r & 15, cc = c & 31, ob = rr * 64 + cc * 2; return st * 1024 + (ob ^ (((ob >> 9) & 1) << 5)); }
DI void stage_rc(int b, int& R, int& C) { const int st = b / 1024, sb = b % 1024, swz = sb ^ (((sb >> 9) & 1) << 5); R = (st >> 1) * 16 + swz / 64; C = (st & 1) * 32 + (swz % 64) / 2; }
DI int perm32(int rho) { const int n = rho >> 4, i = rho & 15; return 8 * (i >> 2) + 4 * n + (i & 3); }
struct Unit { int pm, pn; };
struct Gemm { const bf16_t* A; const bf16_t* Bt; int M, N, K; };
struct StaticOrder {
    int nM, nN, nwg, G, c;
    DI void init(int M, int N, int G_, int c_) { nM = M / BM; nN = N / BM; nwg = nM * nN; G = G_; c = c_; }
    DI bool next(int i, Unit& u) const {
        const long L = (long)i * G + c; if (L >= nwg) return false;
        int wgid = (int)L; { const int q = nwg / NXCD, r = nwg % NXCD, xcd = wgid % NXCD, off = wgid / NXCD; wgid = (xcd < r ? xcd * (q + 1) : r * (q + 1) + (xcd - r) * q) + off; }
        const int nig = WGM * nN, gid = wgid / nig, fm = gid * WGM, gsz = (nM - fm) < WGM ? (nM - fm) : WGM;
        u.pm = fm + ((wgid % nig) % gsz); u.pn = (wgid % nig) / gsz; return true;
    }
};
struct EpiScale {
    static constexpr bool PERM = true;
    bf16_t* O; int ldc; const float* ss;
    DI void operator()(const f32x4 (&acc)[2][2][4][2], const Unit& u, int wr, int wc, int fr, int fq) const {
        const int row0 = u.pm * BM + wr * 64 + fr, col0 = u.pn * BM + wc * 32 + 8 * fq;
        float sc[2][4];
        if (ss) {
            f32x4 pv[2][4];
#pragma unroll
            for (int ai = 0; ai < 2; ++ai)
#pragma unroll
                for (int m = 0; m < 4; ++m) pv[ai][m] = *(const f32x4*)(ss + (size_t)(row0 + ai * HALF + m * 16) * 16 + fq * 4);
#pragma unroll
            for (int ai = 0; ai < 2; ++ai)
#pragma unroll
                for (int m = 0; m < 4; ++m) { float t = (pv[ai][m][0] + pv[ai][m][1]) + (pv[ai][m][2] + pv[ai][m][3]);
                    t += __shfl_xor(t, 16); t += __shfl_xor(t, 32); sc[ai][m] = rsqrtf(t * (1.0f / 1024.0f) + EPS); }
        } else {
#pragma unroll
            for (int ai = 0; ai < 2; ++ai)
#pragma unroll
                for (int m = 0; m < 4; ++m) sc[ai][m] = 1.0f;
        }
#pragma unroll
        for (int ai = 0; ai < 2; ++ai)
#pragma unroll
            for (int m = 0; m < 4; ++m) {
                const int row = row0 + ai * HALF + m * 16;
                bf16_t* rowp = O + (size_t)row * ldc + col0;
#pragma unroll
                for (int bj = 0; bj < 2; ++bj) {
                    const f32x4 v0 = acc[ai][bj][m][0] * sc[ai][m], v1 = acc[ai][bj][m][1] * sc[ai][m];
                    u32x4 w; w.x = pk2(v0[0], v0[1]); w.y = pk2(v0[2], v0[3]); w.z = pk2(v1[0], v1[1]); w.w = pk2(v1[2], v1[3]);
                    *(u32x4*)(rowp + bj * HALF) = w;
                }
            }
    }
};
struct EpiResid {
    static constexpr bool PERM = false;
    bf16_t* xb; float* fout; float* ssn;
    DI void operator()(const f32x4 (&acc)[2][2][4][2], const Unit& u, int wr, int wc, int fr, int fq) const {
        const int row0 = u.pm * BM + wr * 64 + fr, col0 = u.pn * BM + wc * 32 + 4 * fq;
        u32x2 xi[2][4][2][2];
#pragma unroll
        for (int ai = 0; ai < 2; ++ai)
#pragma unroll
            for (int m = 0; m < 4; ++m)
#pragma unroll
                for (int bj = 0; bj < 2; ++bj)
#pragma unroll
                    for (int n = 0; n < 2; ++n) xi[ai][m][bj][n] = *(const u32x2*)(xb + (size_t)(row0 + ai * HALF + m * 16) * 1024 + col0 + bj * HALF + n * 16);
#pragma unroll
        for (int ai = 0; ai < 2; ++ai) {
#pragma unroll
            for (int m = 0; m < 4; ++m) {
                const int row = row0 + ai * HALF + m * 16;
                const size_t off = (size_t)row * 1024 + col0;
                float s = 0.f;
#pragma unroll
                for (int bj = 0; bj < 2; ++bj)
#pragma unroll
                    for (int n = 0; n < 2; ++n) {
                        const size_t o2 = off + bj * HALF + n * 16;
                        f32x4 o; o[0] = bf_lo(xi[ai][m][bj][n].x); o[1] = bf_hi(xi[ai][m][bj][n].x); o[2] = bf_lo(xi[ai][m][bj][n].y); o[3] = bf_hi(xi[ai][m][bj][n].y);
                        o += acc[ai][bj][m][n];
                        if (fout) *(f32x4*)(fout + o2) = o;
                        else { u32x2 w; w.x = pk2(o[0], o[1]); w.y = pk2(o[2], o[3]); *(u32x2*)(xb + o2) = w; }
                        s += (o[0] * o[0] + o[1] * o[1]) + (o[2] * o[2] + o[3] * o[3]);
                    }
                s += __shfl_xor(s, 16); s += __shfl_xor(s, 32);
                if (fq == 0 && ssn) ssn[(size_t)row * 16 + u.pn * 4 + wc] = s;
            }
        }
    }
};

template <class Epi>
DI void gemm_phase(LAS unsigned char* lds, const Gemm g, const StaticOrder& S, const Epi& E) {
    const int tid = TID(), wid = __builtin_amdgcn_readfirstlane(tid >> 6), lane = tid & 63, wr = wid >> 2, wc = wid & 3, fr = lane & 15, fq = lane >> 4;
    const int K = g.K, nt = K / BK;
    unsigned voffA[2], voffB[2];
#pragma unroll
    for (int i = 0; i < 2; ++i) { int R, C; stage_rc(tid * 16 + i * 8192, R, C); const int Rb = Epi::PERM ? ((R & ~31) + perm32(R & 31)) : R;
        voffA[i] = (unsigned)(R * K + C) * 2u; voffB[i] = (unsigned)(Rb * K + C) * 2u; }
    const size_t kstep = (size_t)(BK * 2);
    const size_t hstep = (size_t)HALF * K * 2;
    const size_t tstep = 2 * hstep;
    const unsigned ldsw = (unsigned)wid * 1024u;
    const int aoff = lds_byte(wr * 64 + fr, fq * 8), boff = lds_byte(wc * 32 + fr, fq * 8);
#define PG8_SA(b, h) (((b) * 2 + (h)) * HTB)
#define PG8_SB(b, h) ((4 + (b) * 2 + (h)) * HTB)
#define PG8_STAGE(bufoff, gbase, voff) do { _Pragma("unroll") for (int _i = 0; _i < 2; ++_i) \
        __builtin_amdgcn_global_load_lds((const unsigned*)((const char*)(gbase) + (voff)[_i]), (LAS unsigned*)(lds + (bufoff) + ldsw + _i * 8192), 16, 0, 0); } while (0)
#define PG8_LDA(dst, b, h) do { _Pragma("unroll") for (int m = 0; m < 4; ++m) _Pragma("unroll") for (int k = 0; k < 2; ++k) dst[m][k] = *(const LAS bf16x8*)(lds + PG8_SA(b, h) + aoff + m * 2048 + k * 1024); } while (0)
#define PG8_LDB(dst, b, h) do { _Pragma("unroll") for (int n = 0; n < 2; ++n) _Pragma("unroll") for (int k = 0; k < 2; ++k) dst[n][k] = *(const LAS bf16x8*)(lds + PG8_SB(b, h) + boff + n * 2048 + k * 1024); } while (0)
#define PG8_MMA(ai, bj, At, Bt) do { __builtin_amdgcn_s_setprio(1); _Pragma("unroll") for (int m = 0; m < 4; ++m) _Pragma("unroll") for (int n = 0; n < 2; ++n) _Pragma("unroll") for (int k = 0; k < 2; ++k) \
        acc[ai][bj][m][n] = __builtin_amdgcn_mfma_f32_16x16x32_bf16(Bt[n][k], At[m][k], acc[ai][bj][m][n], 0, 0, 0); __builtin_amdgcn_s_setprio(0); } while (0)
#define PG8_WAIT_V(n) asm volatile("s_waitcnt vmcnt(" #n ")" ::: "memory")
#define PG8_WAIT_L(n) asm volatile("s_waitcnt lgkmcnt(" #n ")" ::: "memory")
#define PG8_BAR __builtin_amdgcn_s_barrier()
#define PG8_SCHED __builtin_amdgcn_sched_barrier(0)
    Unit cur, nxt; int ui = 0;
    if (!S.next(0, cur)) return;
    f32x4 acc[2][2][4][2];
#pragma unroll
    for (int a = 0; a < 2; ++a)
#pragma unroll
        for (int b = 0; b < 2; ++b)
#pragma unroll
            for (int m = 0; m < 4; ++m)
#pragma unroll
                for (int n = 0; n < 2; ++n) acc[a][b][m][n] = (f32x4){0.f, 0.f, 0.f, 0.f};
    bf16x8 At[4][2], B0[2][2], B1[2][2];
    const char* cA = (const char*)g.A + (size_t)cur.pm * tstep; const char* cB = (const char*)g.Bt + (size_t)cur.pn * tstep;
    PG8_STAGE(PG8_SB(0, 0), cB, voffB); PG8_STAGE(PG8_SA(0, 0), cA, voffA); PG8_STAGE(PG8_SB(0, 1), cB + hstep, voffB); PG8_STAGE(PG8_SA(0, 1), cA + hstep, voffA);
    if (wr == 1) PG8_BAR;
    PG8_WAIT_V(4); PG8_BAR;
    PG8_STAGE(PG8_SB(1, 0), cB + kstep, voffB); PG8_STAGE(PG8_SA(1, 0), cA + kstep, voffA); PG8_STAGE(PG8_SB(1, 1), cB + hstep + kstep, voffB);
    PG8_WAIT_V(6); PG8_BAR;
    for (;;) {
        const bool has_next = S.next(ui + 1, nxt);
        const char* nA = has_next ? (const char*)g.A + (size_t)nxt.pm * tstep : cA; const char* nB = has_next ? (const char*)g.Bt + (size_t)nxt.pn * tstep : cB;
        for (int t = 0; t < nt; t += 2) {
            const bool last = (t == nt - 2);
            const char* a1 = cA + (size_t)(t + 1) * kstep;
            const char* a2 = last ? nA : cA + (size_t)(t + 2) * kstep; const char* b2 = last ? nB : cB + (size_t)(t + 2) * kstep;
            const char* a3 = a2 + kstep; const char* b3 = b2 + kstep;
            PG8_LDB(B0, 0, 0); PG8_SCHED; PG8_LDA(At, 0, 0); PG8_STAGE(PG8_SA(1, 1), a1 + hstep, voffA);
            PG8_WAIT_L(8); PG8_BAR; PG8_WAIT_L(0); PG8_MMA(0, 0, At, B0); PG8_BAR; PG8_SCHED;
            PG8_LDB(B1, 0, 1); PG8_STAGE(PG8_SB(0, 0), b2, voffB);
            PG8_BAR; PG8_WAIT_L(0); PG8_MMA(0, 1, At, B1); PG8_BAR;
            PG8_LDA(At, 0, 1); PG8_STAGE(PG8_SA(0, 0), a2, voffA);
            PG8_BAR; PG8_WAIT_L(0); PG8_MMA(1, 0, At, B0); PG8_BAR; PG8_SCHED;
            PG8_STAGE(PG8_SB(0, 1), b2 + hstep, voffB);
            PG8_WAIT_V(6); PG8_BAR; PG8_MMA(1, 1, At, B1); PG8_BAR;
            PG8_LDB(B0, 1, 0); PG8_SCHED; PG8_LDA(At, 1, 0); PG8_STAGE(PG8_SA(0, 1), a2 + hstep, voffA);
            PG8_WAIT_L(8); PG8_BAR; PG8_WAIT_L(0); PG8_MMA(0, 0, At, B0); PG8_BAR; PG8_SCHED;
            PG8_LDB(B1, 1, 1); PG8_STAGE(PG8_SB(1, 0), b3, voffB);
            PG8_BAR; PG8_WAIT_L(0); PG8_MMA(0, 1, At, B1); PG8_BAR;
            PG8_LDA(At, 1, 1); PG8_STAGE(PG8_SA(1, 0), a3, voffA);
            PG8_BAR; PG8_WAIT_L(0); PG8_MMA(1, 0, At, B0); PG8_BAR; PG8_SCHED;
            PG8_STAGE(PG8_SB(1, 1), b3 + hstep, voffB);
            PG8_WAIT_V(6); PG8_BAR; PG8_MMA(1, 1, At, B1); PG8_BAR;
        }
        E(acc, cur, wr, wc, fr, fq);
        if (!has_next) break;
#pragma unroll
        for (int a = 0; a < 2; ++a)
#pragma unroll
            for (int b = 0; b < 2; ++b)
#pragma unroll
                for (int m = 0; m < 4; ++m)
#pragma unroll
                    for (int n = 0; n < 2; ++n) acc[a][b][m][n] = (f32x4){0.f, 0.f, 0.f, 0.f};
        cur = nxt; cA = nA; cB = nB; ++ui;
    }
    PG8_WAIT_V(0);
    if (wr == 0) PG8_BAR;
    PG8_BAR;
#undef PG8_SA
#undef PG8_SB
#undef PG8_STAGE
#undef PG8_LDA
#undef PG8_LDB
#undef PG8_MMA
#undef PG8_WAIT_V
#undef PG8_WAIT_L
#undef PG8_BAR
#undef PG8_SCHED
}
}

DI void wconv(LAS unsigned char* lds, const float* src, int ldsrc, int c0, int ncols, const float* gain, bf16_t* dst, int r0, int K, int& tilebase) {
    LAS float* T = (LAS float*)lds;
    const int tid = TID(), ntn = (ncols + 63) >> 6, ntk = K >> 6, ntile = ntn * ntk;
    const int G = GDIM();
    int first = (BID() - (tilebase % G) + G) % G;
    for (int tile = first; tile < ntile; tile += G) {
        const int tk = tile / ntn, tn = tile % ntn, k0 = tk * 64, n0 = tn * 64;
        const int kk = tid >> 4, j4 = (tid & 15) * 4;
#pragma unroll
        for (int p = 0; p < 2; ++p) {
            const int k = kk + 32 * p, n = n0 + j4;
            f32x4 v = (f32x4){0.f, 0.f, 0.f, 0.f};
            if (n < ncols) v = *(const f32x4*)(src + (size_t)(k0 + k) * ldsrc + c0 + n);
            const float gsc = gain ? gain[k0 + k] : 1.0f;
            T[k * 65 + j4 + 0] = v[0] * gsc; T[k * 65 + j4 + 1] = v[1] * gsc; T[k * 65 + j4 + 2] = v[2] * gsc; T[k * 65 + j4 + 3] = v[3] * gsc;
        }
        bar();
        const int n = tid >> 3, k8 = (tid & 7) * 8;
        if (n0 + n < ncols) {
            float f[8];
#pragma unroll
            for (int q = 0; q < 8; ++q) f[q] = T[(k8 + q) * 65 + n];
            *(u32x4*)(dst + (size_t)(r0 + n0 + n) * K + k0 + k8) = pack8(f);
        }
        bar();
    }
    tilebase += ntile;
}

DI void prologue(AP a, LAS unsigned char* lds) {
    const int tid = TID(), lane = tid & 63, wid = tid >> 6;
    const size_t gtid = (size_t)BID() * 512 + tid, gsz = (size_t)GDIM() * 512;
    unsigned char* ws = a->ws;
    { f32x4 z = (f32x4){0.f, 0.f, 0.f, 0.f};
      f32x4* pc = (f32x4*)(ws + O_CTR); for (size_t i = gtid; i < 4096 / 16; i += gsz) pc[i] = z;
      f32x4* p0 = (f32x4*)(ws + O_WIN0 + (size_t)2576 * 1024 * 2); for (size_t i = gtid; i < (size_t)(NPAD0 - 2576) * 1024 * 2 / 16; i += gsz) p0[i] = z;
      f32x4* p2 = (f32x4*)(ws + O_WIN2 + (size_t)2316 * 1024 * 2); for (size_t i = gtid; i < (size_t)(NPAD2 - 2316) * 1024 * 2 / 16; i += gsz) p2[i] = z; }
    { const float* x = a->in[0]; bf16_t* xb = (bf16_t*)(ws + O_XB); float* ss0 = (float*)(ws + O_SS);
      for (int row = BID() * 8 + wid; row < NTOK; row += GDIM() * 16) {
          const int row2 = row + GDIM() * 8; const bool ok2 = row2 < NTOK;
          f32x4 va[4], vb[4];
#pragma unroll
          for (int i = 0; i < 4; ++i) { va[i] = ((const f32x4*)(x + (size_t)row * 1024))[lane + 64 * i]; vb[i] = ((const f32x4*)(x + (size_t)(ok2 ? row2 : row) * 1024))[lane + 64 * i]; }
          float s = 0.f, s2 = 0.f;
#pragma unroll
          for (int i = 0; i < 4; ++i) { s += va[i][0] * va[i][0] + va[i][1] * va[i][1] + va[i][2] * va[i][2] + va[i][3] * va[i][3]; s2 += vb[i][0] * vb[i][0] + vb[i][1] * vb[i][1] + vb[i][2] * vb[i][2] + vb[i][3] * vb[i][3];
              u32x2 w; w.x = pk2(va[i][0], va[i][1]); w.y = pk2(va[i][2], va[i][3]); *(u32x2*)(xb + (size_t)row * 1024 + (lane + 64 * i) * 4) = w;
              if (ok2) { u32x2 w2; w2.x = pk2(vb[i][0], vb[i][1]); w2.y = pk2(vb[i][2], vb[i][3]); *(u32x2*)(xb + (size_t)row2 * 1024 + (lane + 64 * i) * 4) = w2; } }
          s = wave_sum(s); s2 = wave_sum(s2);
          if (lane < 16) { ss0[(size_t)row * 16 + lane] = lane == 0 ? s : 0.f; if (ok2) ss0[(size_t)row2 * 16 + lane] = lane == 0 ? s2 : 0.f; }
      }
      const float* mem = a->in[1]; bf16_t* mn = (bf16_t*)(ws + O_MEMN);
      for (int row = BID() * 8 + wid; row < 2048; row += GDIM() * 8) {
          const f32x4* p = (const f32x4*)(mem + (size_t)row * 1024); float s = 0.f; f32x4 v[4];
#pragma unroll
          for (int i = 0; i < 4; ++i) { v[i] = p[lane + 64 * i]; s += v[i][0] * v[i][0] + v[i][1] * v[i][1] + v[i][2] * v[i][2] + v[i][3] * v[i][3]; }
          s = wave_sum(s); const float sc = rsqrtf(s * (1.0f / 1024.0f) + EPS);
#pragma unroll
          for (int i = 0; i < 4; ++i) { u32x2 w; w.x = pk2(v[i][0] * sc, v[i][1] * sc); w.y = pk2(v[i][2] * sc, v[i][3] * sc); *(u32x2*)(mn + (size_t)row * 1024 + (lane + 64 * i) * 4) = w; }
      } }
    { const int* pos = (const int*)a->in[2]; unsigned* rp = (unsigned*)(ws + O_ROPE);
      for (size_t i = gtid; i < (size_t)NTOK * 64; i += gsz) {
          const int row = (int)(i >> 6), j = (int)(i & 63);
          const float invf = exp2f(-(float)j * (13.287712379549449f / 64.0f));
          double rev = (double)pos[row] * (double)invf * 0.15915494309189535;
          rev = rev - floor(rev);
          const float fr = (float)rev;
          const float c = __builtin_amdgcn_cosf(fr), s = __builtin_amdgcn_sinf(fr);
          const _Float16 hc = (_Float16)c, hs = (_Float16)s;
          rp[i] = (unsigned)__builtin_bit_cast(unsigned short, hc) | ((unsigned)__builtin_bit_cast(unsigned short, hs) << 16);
      } }
    int tb = 0;
    const float* mixn = a->in[4]; const float* ffnn = a->in[8];
    wconv(lds, a->in[13], 2576, 0, 2576, mixn + 0 * 1024, (bf16_t*)(ws + O_WIN0), 0, 1024, tb);
    wconv(lds, a->in[18], 4864, 0, 4864, mixn + 1 * 1024, (bf16_t*)(ws + O_WIN1), 0, 1024, tb);
    wconv(lds, a->in[22], 2316, 0, 2048, mixn + 2 * 1024, (bf16_t*)(ws + O_WIN2), 0, 1024, tb);
    wconv(lds, a->in[22], 2316, 2060, 256, mixn + 2 * 1024, (bf16_t*)(ws + O_WIN2), 2048, 1024, tb);
    wconv(lds, a->in[22], 2316, 2048, 12, mixn + 2 * 1024, (bf16_t*)(ws + O_WIN2), 2304, 1024, tb);
    wconv(lds, a->in[30], 3328, 0, 3328, mixn + 3 * 1024, (bf16_t*)(ws + O_WIN3), 0, 1024, tb);
    wconv(lds, a->in[17], 1024, 0, 1024, nullptr, (bf16_t*)(ws + O_WOUT0), 0, 1024, tb);
    wconv(lds, a->in[21], 1024, 0, 1024, nullptr, (bf16_t*)(ws + O_WOUT1), 0, 768, tb);
    wconv(lds, a->in[29], 1024, 0, 1024, nullptr, (bf16_t*)(ws + O_WOUT2), 0, 1024, tb);
    wconv(lds, a->in[33], 1024, 0, 1024, nullptr, (bf16_t*)(ws + O_WOUT3), 0, 1024, tb);
    for (int l = 0; l < 4; ++l) {
        wconv(lds, a->in[9] + (size_t)l * 1024 * 5632, 5632, 0, 5632, ffnn + l * 1024, (bf16_t*)(ws + O_WUP) + (size_t)l * 5632 * 1024, 0, 1024, tb);
        wconv(lds, a->in[12] + (size_t)l * 2816 * 1024, 1024, 0, 1024, nullptr, (bf16_t*)(ws + O_WDN) + (size_t)l * 1024 * 2816, 0, 2816, tb);
        wconv(lds, a->in[5] + (size_t)l * 1024 * 512, 512, 0, 512, a->in[3], (bf16_t*)(ws + O_WKV), l * 512, 1024, tb);
    }
}

template <int HD, bool DIL>
struct AttnCfg {
    static constexpr int KSP = HD + 8;
    static constexpr int VTP = 320;
    static constexpr int KS_BYTES = 256 * KSP * 2;
    static constexpr int VT_OFF = KS_BYTES;
    static constexpr int NKT = DIL ? 9 : 16;
    static constexpr int NKS = (NKT + 1) / 2;
    static constexpr int NS = HD / 32;
    static constexpr int NDT = HD / 16;
};
DI int vt_swz(int d, int key) { return key ^ (((d >> 3) & 15) << 2); }

template <int STEP, int BASE>
DI void tr_read4(unsigned addr, s16x4 (&o)[4]) {
    asm volatile("ds_read_b64_tr_b16 %0, %4 offset:%5\n\tds_read_b64_tr_b16 %1, %4 offset:%6\n\tds_read_b64_tr_b16 %2, %4 offset:%7\n\tds_read_b64_tr_b16 %3, %4 offset:%8\n\ts_waitcnt lgkmcnt(0)"
                 : "=&v"(o[0]), "=&v"(o[1]), "=&v"(o[2]), "=&v"(o[3]) : "v"(addr), "n"(BASE), "n"(BASE + STEP), "n"(BASE + 2 * STEP), "n"(BASE + 3 * STEP) : "memory");
}

template <int HD, bool DIL>
DI void attn_tile(LAS unsigned char* lds, const bf16_t* qsrc, size_t qstride, const bf16_t* ksrc, const bf16_t* vsrc, size_t kstride,
                  const float* qg, const float* kg, const unsigned* ropeq, size_t ropeq_stride, const unsigned* ropek, size_t ropek_stride,
                  int nblk  , bf16_t* osrc, size_t ostride, float* lse, size_t lse_stride, bool wr = true) {
    typedef AttnCfg<HD, DIL> C;
    const int tid = TID(), lane = tid & 63, wid = tid >> 6, r = lane & 15, q = lane >> 4;
    LAS bf16_t* KS = (LAS bf16_t*)lds;
    LAS bf16_t* VT = (LAS bf16_t*)(lds + C::VT_OFF);
    bar();
    constexpr int VPR = HD / 8;
    constexpr int NIT = 256 * VPR / 512;
    const int qrow = 16 * wid + r;
    u32x4 qraw[C::NS], qc0[2], qc1[2];
#pragma unroll
    for (int s = 0; s < C::NS; ++s) qraw[s] = *(const u32x4*)(qsrc + (size_t)qrow * qstride + 32 * s + 8 * q);
    if (DIL) {
#pragma unroll
        for (int s = 0; s < 2; ++s) { qc0[s] = *(const u32x4*)(ropeq + (size_t)qrow * ropeq_stride + 32 * s + 8 * q); qc1[s] = *(const u32x4*)(ropeq + (size_t)qrow * ropeq_stride + 32 * s + 8 * q + 4); }
    }
    float kgv[8];
#pragma unroll
    for (int i = 0; i < 8; ++i) kgv[i] = kg[(tid % VPR) * 8 + i];
#pragma unroll
    for (int bb = 0; bb < NIT; bb += 4) {
        u32x4 kwv[4], vwv[4], cwv[4], cw2v[4];
#pragma unroll
        for (int u = 0; u < 4; ++u) {
            const int e = tid + 512 * (bb + u); const int key = e / VPR, dv = e % VPR;
            const bool valid = !DIL || nblk > 0 || key >= 128;
            const long krow = DIL ? (long)key - 128 : (long)key;
            kwv[u] = (u32x4){0u, 0u, 0u, 0u}; vwv[u] = kwv[u]; cwv[u] = kwv[u]; cw2v[u] = kwv[u];
            if (valid) { kwv[u] = *(const u32x4*)(ksrc + krow * (long)kstride + dv * 8); vwv[u] = *(const u32x4*)(vsrc + krow * (long)kstride + dv * 8);
                if (DIL) { cwv[u] = *(const u32x4*)(ropek + krow * (long)ropek_stride + (dv & 7) * 8); cw2v[u] = *(const u32x4*)(ropek + krow * (long)ropek_stride + (dv & 7) * 8 + 4); } }
        }
#pragma unroll
        for (int u = 0; u < 4; ++u) {
            const int e = tid + 512 * (bb + u); const int key = e / VPR, dv = e % VPR;
            float kf[8]; unpack8(kwv[u], kf);
            float ssq = 0.f;
#pragma unroll
            for (int i = 0; i < 8; ++i) ssq += kf[i] * kf[i];
#pragma unroll
            for (int o = 1; o < VPR; o <<= 1) ssq += __shfl_xor(ssq, o);
            const float sc = rsqrtf(ssq * (1.0f / HD) + EPS);
#pragma unroll
            for (int i = 0; i < 8; ++i) kf[i] *= sc * kgv[i];
            if (DIL) {
                float pf[8];
#pragma unroll
                for (int i = 0; i < 8; ++i) pf[i] = __shfl_xor(kf[i], 8);
                const unsigned cs[8] = {cwv[u].x, cwv[u].y, cwv[u].z, cwv[u].w, cw2v[u].x, cw2v[u].y, cw2v[u].z, cw2v[u].w};
#pragma unroll
                for (int i = 0; i < 8; ++i) {
                    const float c = (float)__builtin_bit_cast(_Float16, (unsigned short)(cs[i] & 0xffffu)), sn = (float)__builtin_bit_cast(_Float16, (unsigned short)(cs[i] >> 16));
                    kf[i] = (dv < 8) ? (kf[i] * c - pf[i] * sn) : (kf[i] * c + pf[i] * sn);
                }
            }
            *(LAS u32x4*)(KS + key * C::KSP + dv * 8) = pack8(kf);
            *(LAS u32x4*)(VT + key * C::KSP + dv * 8) = vwv[u];
        }
    }
    float qf[C::NS][8];
    { float ssq = 0.f;
#pragma unroll
      for (int s = 0; s < C::NS; ++s) { unpack8(qraw[s], qf[s]);
#pragma unroll
          for (int i = 0; i < 8; ++i) ssq += qf[s][i] * qf[s][i]; }
      ssq += __shfl_xor(ssq, 16); ssq += __shfl_xor(ssq, 32);
      const float sc = rsqrtf(ssq * (1.0f / HD) + EPS);
#pragma unroll
      for (int s = 0; s < C::NS; ++s)
#pragma unroll
          for (int i = 0; i < 8; ++i) qf[s][i] *= sc * qg[32 * s + 8 * q + i];
      if (DIL) {
#pragma unroll
          for (int s = 0; s < 2; ++s) {
              const u32x4 c0 = qc0[s], c1 = qc1[s];
              const unsigned cs[8] = {c0.x, c0.y, c0.z, c0.w, c1.x, c1.y, c1.z, c1.w};
#pragma unroll
              for (int i = 0; i < 8; ++i) {
                  const float c = (float)__builtin_bit_cast(_Float16, (unsigned short)(cs[i] & 0xffffu)), sn = (float)__builtin_bit_cast(_Float16, (unsigned short)(cs[i] >> 16));
                  const float x1 = qf[s][i], x2 = qf[s + 2][i];
                  qf[s][i] = x1 * c - x2 * sn; qf[s + 2][i] = x2 * c + x1 * sn;
              }
          }
      }
      const float qs = 1.4426950408889634f * (HD == 128 ? 0.08838834764831845f : 0.125f);
#pragma unroll
      for (int s = 0; s < C::NS; ++s)
#pragma unroll
          for (int i = 0; i < 8; ++i) qf[s][i] *= qs;
    }
    bf16x8 qfrag[C::NS];
#pragma unroll
    for (int s = 0; s < C::NS; ++s) { const u32x4 w = pack8(qf[s]); qfrag[s] = __builtin_bit_cast(bf16x8, w); }
    bar();
    const int kt0 = DIL ? wid : 0;
    f32x4 sacc[C::NKT];
#pragma unroll
    for (int t = 0; t < C::NKT; ++t) {
        sacc[t] = (f32x4){0.f, 0.f, 0.f, 0.f};
#pragma unroll
        for (int s = 0; s < C::NS; ++s) {
            const bf16x8 kfr = *(const LAS bf16x8*)(KS + ((kt0 + t) * 16 + r) * C::KSP + 32 * s + 8 * q);
            sacc[t] = MFMA16(kfr, qfrag[s], sacc[t]);
        }
    }
    float mx = -3.0e38f;
#pragma unroll
    for (int t = 0; t < C::NKT; ++t)
#pragma unroll
        for (int i = 0; i < 4; ++i) {
            if (DIL) { const int j = (kt0 + t) * 16 + 4 * q + i, dist = 128 + qrow - j; const bool ok = dist >= 0 && dist <= 128 && (nblk > 0 || j >= 128); if (!ok) sacc[t][i] = -3.0e38f; }
            mx = fmaxf(mx, sacc[t][i]);
        }
    mx = fmaxf(mx, __shfl_xor(mx, 16)); mx = fmaxf(mx, __shfl_xor(mx, 32));
    float l = 0.f;
#pragma unroll
    for (int t = 0; t < C::NKT; ++t)
#pragma unroll
        for (int i = 0; i < 4; ++i) { const float p = __builtin_amdgcn_exp2f(sacc[t][i] - mx); sacc[t][i] = p; l += p; }
    l += __shfl_xor(l, 16); l += __shfl_xor(l, 32);
    f32x4 oacc[C::NDT];
#pragma unroll
    for (int dt = 0; dt < C::NDT; ++dt) oacc[dt] = (f32x4){0.f, 0.f, 0.f, 0.f};
#pragma unroll
    for (int s = 0; s < C::NKS; ++s) {
        const bool has2 = (2 * s + 1) < C::NKT;
        u32x4 pw; pw.x = pk2(sacc[2 * s][0], sacc[2 * s][1]); pw.y = pk2(sacc[2 * s][2], sacc[2 * s][3]);
        if (has2) { pw.z = pk2(sacc[(2 * s + 1) < C::NKT ? 2 * s + 1 : 0][0], sacc[(2 * s + 1) < C::NKT ? 2 * s + 1 : 0][1]); pw.w = pk2(sacc[(2 * s + 1) < C::NKT ? 2 * s + 1 : 0][2], sacc[(2 * s + 1) < C::NKT ? 2 * s + 1 : 0][3]); }
        else { pw.z = 0u; pw.w = 0u; }
        const bf16x8 pfrag = __builtin_bit_cast(bf16x8, pw);
        const int key0 = (kt0 + 2 * s) * 16 + 4 * q, key1 = has2 ? key0 + 16 : key0;
        (void)key1;
        const unsigned vaddr = (unsigned)(size_t)(VT + (key0 + (r >> 2)) * C::KSP + 4 * (r & 3));
#pragma unroll
        for (int dg = 0; dg < C::NDT; dg += 4) {
            s16x4 lo[4], hi[4];
            if (dg == 0) { tr_read4<32, 0>(vaddr, lo); if (has2) tr_read4<32, 16 * C::KSP * 2>(vaddr, hi); else tr_read4<32, 0>(vaddr, hi); }
            else         { tr_read4<32, 128>(vaddr, lo); if (has2) tr_read4<32, 16 * C::KSP * 2 + 128>(vaddr, hi); else tr_read4<32, 128>(vaddr, hi); }
#pragma unroll
            for (int j = 0; j < 4; ++j) { const bf16x8 va = __builtin_shufflevector(lo[j], hi[j], 0, 1, 2, 3, 4, 5, 6, 7); oacc[dg + j] = MFMA16(va, pfrag, oacc[dg + j]); }
        }
    }
    const float il = __builtin_amdgcn_rcpf(l);
#pragma unroll
    for (int dt = 0; dt < C::NDT; ++dt) {
        const f32x4 o = oacc[dt] * il;
        u32x2 w; w.x = pk2(o[0], o[1]); w.y = pk2(o[2], o[3]);
        if (wr) *(u32x2*)(osrc + (size_t)qrow * ostride + dt * 16 + 4 * q) = w;
    }
    if (DIL && q == 0 && wr) lse[(size_t)qrow * lse_stride] = (mx + __builtin_amdgcn_logf(l)) * 0.6931471805599453f;
}

DI void xa_tile(AP a, LAS unsigned char* lds, int layer, int t_, const bf16_t* proj, int ldp, int xqcol, bf16_t* mix, int ldm, int xacol) {
    const int t = t_ & 2047; const int qt = t & 63, h = (t >> 6) & 3, b = t >> 8;
    const bf16_t* kvm = (const bf16_t*)(a->ws + O_KVM);
    const size_t row0 = (size_t)b * SEQ + (size_t)qt * 128;
    attn_tile<64, false>(lds, proj + row0 * ldp + xqcol + h * 64, (size_t)ldp,
                         kvm + (size_t)(b * 256) * 2048 + layer * 512 + h * 64, kvm + (size_t)(b * 256) * 2048 + layer * 512 + 256 + h * 64, 2048,
                         a->in[6] + layer * 64, a->in[7] + layer * 64, nullptr, 0, nullptr, 0, 1,
                         mix + row0 * ldm + xacol + h * 64, (size_t)ldm, nullptr, 0);
}
DI void dil_tile(AP a, LAS unsigned char* lds, int t_, bf16_t* proj) {
    const int t = t_ % 6144; const bool wr = t_ >= 6144 * (DUP_DIL - 1);
    const int blk = t & 63, hh = (t >> 6) % 12, b = t / 768;
    const int g = hh >> 2, rr = (g == 0) ? 1 : (g == 1 ? 4 : 16);
    const int nb = 64 / rr;
    const int rho = blk / nb, n = blk % nb;
    const size_t tok0 = (size_t)b * SEQ + rho + (size_t)rr * 128 * n;
    const unsigned* rope = (const unsigned*)(a->ws + O_ROPE);
    float* lse = (float*)(a->ws + O_LSE) + ((size_t)g * NTOK + tok0) * 4 + (hh & 3);
    bf16_t* qp = proj + tok0 * 4864 + hh * 128;
    attn_tile<128, true>(lds, qp, (size_t)rr * 4864, proj + tok0 * 4864 + 1536 + hh * 128, proj + tok0 * 4864 + 3072 + hh * 128, (size_t)rr * 4864,
                         a->in[19], a->in[20], rope + tok0 * 64, (size_t)rr * 64, rope + tok0 * 64, (size_t)rr * 64, n,
                         qp, (size_t)rr * 4864, lse, (size_t)rr * 4, wr);
}

DI int tsw(int row, int t) { return ((((t >> 3) ^ (row >> 3)) & 7) << 3) | (t & 7); }

template <int KIND>
DI void scan_unit(AP a, LAS unsigned char* lds, int unit, const bf16_t* proj, bf16_t* mix) {
    constexpr int K = KIND == 0 ? 96 : 128;
    constexpr int V = KIND == 0 ? 192 : (KIND == 2 ? 64 : 128);
    constexpr int H = KIND == 0 ? 4 : (KIND == 2 ? 12 : 6);
    constexpr int NVS = V / 32, KP = K + 8, K8 = K / 8, NST = K / 32, NKT = K / 16;
    constexpr int LDP = KIND == 0 ? NPAD0 : (KIND == 2 ? NPAD2 : NPAD3);
    const int tid = TID(), lane = tid & 63, wid = tid >> 6, r = lane & 15, q = lane >> 4;
    const int vs = unit % NVS, h = (unit / NVS) % H, b = unit / (NVS * H);
    constexpr int B_QT = 0, B_KT = B_QT + 64 * KP * 2, B_QI = B_KT + 64 * KP * 2, B_KTT = B_QI + (KIND == 2 ? 64 * KP * 2 : 0),
                  B_VT = B_KTT + K * 72 * 2, B_ATT = B_VT + 32 * 72 * 2, B_ST = B_ATT + 64 * 72 * 2, B_FD = B_ST + 32 * KP * 2, B_FC = B_FD + K * 4,
                  B_X = B_FC + K * 4;
    LAS bf16_t* QT = (LAS bf16_t*)(lds + B_QT); LAS bf16_t* KT = (LAS bf16_t*)(lds + B_KT); LAS bf16_t* QI = (LAS bf16_t*)(lds + B_QI);
    LAS bf16_t* KTT = (LAS bf16_t*)(lds + B_KTT); LAS bf16_t* VT = (LAS bf16_t*)(lds + B_VT); LAS bf16_t* ATT = (LAS bf16_t*)(lds + B_ATT);
    LAS bf16_t* ST = (LAS bf16_t*)(lds + B_ST); LAS float* FD = (LAS float*)(lds + B_FD); LAS float* FC = (LAS float*)(lds + B_FC);
    LAS float* LA = (LAS float*)(lds + B_X);
    LAS float* BC = LA + 64 * K;
    LAS float* XT = BC + 64 * K;
    LAS bf16_t* RAW = (LAS bf16_t*)(lds + B_X);
    LAS float* CW = (LAS float*)(lds + B_X + 67 * 288 * 2 + 32);
    LAS float* CBs = CW + 4 * 288; LAS float* ACS = CBs + 288; LAS float* DTS = ACS + 64; LAS float* XS = DTS + 64;
    static_assert(B_X + (KIND == 2 ? 67 * 288 * 2 + 32 + (5 * 288 + 128 + 64 * 32) * 4 : (2 * 64 * K + 16 * 96 + 96 + 64 * 16) * 4) <= LDS_BYTES, "scan LDS");

    bar();
    float Ah = 0.f, Dh = 0.f, dtb = 0.f;
    if (KIND == 0) {
        const float* w2 = a->in[14]; const float* bg = a->in[15];
        for (int i = tid; i < 16 * 96; i += 512) XT[i] = w2[(i / 96) * 384 + h * 96 + (i % 96)];
        if (tid < 96) XT[16 * 96 + tid] = bg[h * 96 + tid];
    } else if (KIND == 3) {
        const float* lbp = a->in[31];
        if (tid < 128) { const int c = h * 128 + tid; const float v0 = lbp[c], v1 = lbp[768 + c], v2 = lbp[1536 + c], v3 = lbp[2304 + c];
            const float m = fmaxf(fmaxf(v0, v1), fmaxf(v2, v3)); const float e0 = __expf(v0 - m), e1 = __expf(v1 - m), e2 = __expf(v2 - m), e3 = __expf(v3 - m);
            XT[tid] = (e1 + e2 + e3) / (e0 + e1 + e2 + e3); }
    } else {
        const float* cw = a->in[23]; const float* cb = a->in[24];
        const int g = h / 6;
        for (int i = tid; i < 288; i += 512) { const int ch = i < 32 ? (h * 64 + vs * 32 + i) : (i < 160 ? 768 + g * 128 + (i - 32) : 1024 + g * 128 + (i - 160));
#pragma unroll
            for (int j = 0; j < 4; ++j) CW[j * 288 + i] = cw[j * 1280 + ch];
            CBs[i] = cb[ch]; }
        Ah = -__expf(a->in[26][h]); Dh = a->in[27][h]; dtb = a->in[25][h];
    }
    bar();
    f32x4 Sacc[2];
    Sacc[0] = (f32x4){0.f, 0.f, 0.f, 0.f}; Sacc[1] = Sacc[0];
    const size_t rowb = (size_t)b * SEQ;
    constexpr int QCOL = 0, KCOL = KIND == 0 ? 384 : 768  , VCOL = KIND == 0 ? 768 : 1536  ;

    for (int c = 0; c < SEQ / 64; ++c) {
        const size_t row0 = rowb + (size_t)c * 64;
        if (KIND != 2) {
            u32x4 qw[2], kw[2];
#pragma unroll
            for (int p = 0; p < 2; ++p) { const int e = tid + 512 * p; qw[p] = (u32x4){0u, 0u, 0u, 0u}; kw[p] = qw[p];
                if (e < 64 * K8) { const int t = e / K8, k8 = (e % K8) * 8; const bf16_t* rp = proj + (row0 + t) * LDP + h * K + k8;
                    qw[p] = *(const u32x4*)(rp + QCOL); kw[p] = *(const u32x4*)(rp + KCOL); } }
            u32x4 vw = (u32x4){0u, 0u, 0u, 0u};
            if (tid < 256) vw = *(const u32x4*)(proj + (row0 + (tid >> 2)) * LDP + VCOL + h * V + vs * 32 + (tid & 3) * 8);
            float omf[2][8];
            if (KIND == 0) {
                LAS float* GLR = XT + 16 * 96 + 96;
                if (tid < 128) { const int t = tid >> 1, hf = tid & 1; const u32x4 w = *(const u32x4*)(proj + (row0 + t) * LDP + 1536 + hf * 8); float f[8]; unpack8(w, f);
#pragma unroll
                    for (int i = 0; i < 8; ++i) GLR[t * 16 + hf * 8 + i] = f[i]; }
                bar();
#pragma unroll
                for (int p = 0; p < 2; ++p) { const int e = tid + 512 * p;
                    if (e < 64 * K8) { const int t = e / K8, k8 = (e % K8) * 8; float acc8[8];
#pragma unroll
                        for (int i = 0; i < 8; ++i) acc8[i] = XT[16 * 96 + k8 + i];
#pragma unroll
                        for (int rr = 0; rr < 16; ++rr) { const float gv = GLR[t * 16 + rr];
#pragma unroll
                            for (int i = 0; i < 8; ++i) acc8[i] += gv * XT[rr * 96 + k8 + i]; }
#pragma unroll
                        for (int i = 0; i < 8; ++i) { const float x = acc8[i]; LA[t * K + k8 + i] = (fminf(x, 0.f) - __logf(1.0f + __expf(-fabsf(x)))) * (1.0f / 16.0f); } } }
            } else {
#pragma unroll
                for (int p = 0; p < 2; ++p) { const int e = tid + 512 * p; const int t = e / K8, k8 = (e % K8) * 8; float f[8]; unpack8(kw[p], f);
#pragma unroll
                    for (int i = 0; i < 8; ++i) { const float lb = XT[k8 + i]; const float fg = lb + (1.0f - lb) * sigmoidf_(f[i]); omf[p][i] = 1.0f - fg; LA[t * K + k8 + i] = __logf(fg); } }
            }
            bar();
            for (int it = tid; it < K * 8; it += 512) { const int k = it % K, seg = it / K; float pre = 0.f;
                for (int t = 0; t < seg * 8; ++t) pre += LA[t * K + k];
#pragma unroll
                for (int i = 0; i < 8; ++i) { pre += LA[(seg * 8 + i) * K + k]; BC[(seg * 8 + i) * K + k] = pre; } }
            bar();
#pragma unroll
            for (int p = 0; p < 2; ++p) { const int e = tid + 512 * p;
                if (e < 64 * K8) { const int t = e / K8, k8 = (e % K8) * 8; float qv[8], kv[8]; unpack8(qw[p], qv); unpack8(kw[p], kv);
#pragma unroll
                    for (int i = 0; i < 8; ++i) { const float bb = BC[t * K + k8 + i], br = BC[31 * K + k8 + i]; const float ea = __expf(bb - br), eb = __expf(br - bb);
                        if (KIND == 0) { qv[i] = qv[i] * 0.10206207261596575f * ea; kv[i] = kv[i] * eb; }
                        else { qv[i] = siluf_(qv[i]) * ea; kv[i] = omf[p][i] * eb; } }
                    const u32x4 qp = pack8(qv), kp = pack8(kv);
                    *(LAS u32x4*)(QT + t * KP + k8) = qp; *(LAS u32x4*)(KT + t * KP + k8) = kp;
                    const unsigned kk[4] = {kp.x, kp.y, kp.z, kp.w};
#pragma unroll
                    for (int i = 0; i < 8; ++i) KTT[(k8 + i) * 72 + tsw(k8 + i, t)] = (bf16_t)((i & 1) ? (kk[i >> 1] >> 16) : (kk[i >> 1] & 0xffffu)); } }
            if (tid < 256) { const int t = tid >> 2, v8 = (tid & 3) * 8; const unsigned vv[4] = {vw.x, vw.y, vw.z, vw.w};
#pragma unroll
                for (int i = 0; i < 8; ++i) VT[(v8 + i) * 72 + tsw(v8 + i, t)] = (bf16_t)((i & 1) ? (vv[i >> 1] >> 16) : (vv[i >> 1] & 0xffffu)); }
            if (tid < K) { FD[tid] = __expf(BC[63 * K + tid]); FC[tid] = __expf(BC[63 * K + tid] - BC[31 * K + tid]); }
            if (wid < NKT) {
#pragma unroll
                for (int vt = 0; vt < 2; ++vt) { const int k0 = wid * 16 + q * 4; float s4[4];
#pragma unroll
                    for (int i = 0; i < 4; ++i) s4[i] = Sacc[vt][i] * __expf(BC[31 * K + k0 + i]);
                    u32x2 w; w.x = pk2(s4[0], s4[1]); w.y = pk2(s4[2], s4[3]); *(LAS u32x2*)(ST + (vt * 16 + r) * KP + k0) = w; } }
        } else {
            const int g = h / 6;
            for (int e = tid; e < 67 * 36; e += 512) { const int rw = e / 36, cv = e % 36; const long t = (long)c * 64 + rw - 3;
                const int col = cv < 4 ? (768 + h * 64 + vs * 32 + cv * 8) : (cv < 20 ? 1536 + g * 128 + (cv - 4) * 8 : 1792 + g * 128 + (cv - 20) * 8);
                u32x4 w = (u32x4){0u, 0u, 0u, 0u}; if (t >= 0) w = *(const u32x4*)(proj + (rowb + t) * LDP + col);
                *(LAS u32x4*)(RAW + rw * 288 + cv * 8) = w; }
            if (wid == 0) { const float dr = bf2f(proj[(row0 + lane) * LDP + 2304 + h]) + dtb; const float dt = dr > 20.f ? dr : __logf(1.0f + __expf(dr));
                float cs = dt * Ah;
#pragma unroll
                for (int o = 1; o < 64; o <<= 1) { const float n = __shfl_up(cs, o); if (lane >= o) cs += n; }
                ACS[lane] = cs; DTS[lane] = dt; }
            bar();
            const float acl = ACS[63];
            for (int e = tid; e < 64 * 36; e += 512) { const int t = e / 36, cv = e % 36; float val[8];
#pragma unroll
                for (int i = 0; i < 8; ++i) val[i] = CBs[cv * 8 + i];
#pragma unroll
                for (int j = 0; j < 4; ++j) { const u32x4 w = *(const LAS u32x4*)(RAW + (t + j) * 288 + cv * 8); float f[8]; unpack8(w, f);
#pragma unroll
                    for (int i = 0; i < 8; ++i) val[i] += CW[j * 288 + cv * 8 + i] * f[i]; }
#pragma unroll
                for (int i = 0; i < 8; ++i) val[i] = siluf_(val[i]);
                if (cv < 4) { const float dt = DTS[t];
#pragma unroll
                    for (int i = 0; i < 8; ++i) { XS[t * 32 + cv * 8 + i] = val[i]; VT[(cv * 8 + i) * 72 + tsw(cv * 8 + i, t)] = f2bf(val[i] * dt); } }
                else if (cv < 20) { const int k8 = (cv - 4) * 8; *(LAS u32x4*)(KT + t * KP + k8) = pack8(val); const float e2 = __expf(acl - ACS[t]);
#pragma unroll
                    for (int i = 0; i < 8; ++i) KTT[(k8 + i) * 72 + tsw(k8 + i, t)] = f2bf(val[i] * e2); }
                else { const int k8 = (cv - 20) * 8; *(LAS u32x4*)(QT + t * KP + k8) = pack8(val); const float e1 = __expf(ACS[t]);
#pragma unroll
                    for (int i = 0; i < 8; ++i) val[i] *= e1;
                    *(LAS u32x4*)(QI + t * KP + k8) = pack8(val); } }
            if (tid < K) { FD[tid] = __expf(acl); FC[tid] = 1.0f; }
#pragma unroll
            for (int vt = 0; vt < 2; ++vt) { const int k0 = wid * 16 + q * 4; u32x2 w; w.x = pk2(Sacc[vt][0], Sacc[vt][1]); w.y = pk2(Sacc[vt][2], Sacc[vt][3]); *(LAS u32x2*)(ST + (vt * 16 + r) * KP + k0) = w; }
        }
        bar();
        { const int it = wid >> 1;
#pragma unroll
          for (int jj = 0; jj < 2; ++jj) { const int jt = 2 * (wid & 1) + jj; f32x4 acc = (f32x4){0.f, 0.f, 0.f, 0.f};
#pragma unroll
              for (int s = 0; s < NST; ++s) { const bf16x8 kf = *(const LAS bf16x8*)(KT + (jt * 16 + r) * KP + 32 * s + 8 * q); const bf16x8 qf = *(const LAS bf16x8*)(QT + (it * 16 + r) * KP + 32 * s + 8 * q);
                  acc = MFMA16(kf, qf, acc); }
              const int i = it * 16 + r;
#pragma unroll
              for (int ii = 0; ii < 4; ++ii) { const int j = jt * 16 + 4 * q + ii; float v = acc[ii];
                  if (KIND == 2) v *= (j <= i) ? __expf(ACS[i] - ACS[j]) : 0.f;
                  acc[ii] = (j <= i) ? v : 0.f; }
              u32x2 w; w.x = pk2(acc[0], acc[1]); w.y = pk2(acc[2], acc[3]); *(LAS u32x2*)(ATT + i * 72 + jt * 16 + 4 * q) = w; } }
        bar();
        { const int it = wid >> 1, vt = wid & 1; f32x4 o = (f32x4){0.f, 0.f, 0.f, 0.f};
#pragma unroll
          for (int s = 0; s < 2; ++s) { const int vr = vt * 16 + r; const bf16x8 vf = *(const LAS bf16x8*)(VT + vr * 72 + tsw(vr, 32 * s + 8 * q)); const bf16x8 af = *(const LAS bf16x8*)(ATT + (it * 16 + r) * 72 + 32 * s + 8 * q);
              o = MFMA16(vf, af, o); }
          LAS bf16_t* QX = (KIND == 2) ? QI : QT;
#pragma unroll
          for (int s = 0; s < NST; ++s) { const bf16x8 sf = *(const LAS bf16x8*)(ST + (vt * 16 + r) * KP + 32 * s + 8 * q); const bf16x8 qf = *(const LAS bf16x8*)(QX + (it * 16 + r) * KP + 32 * s + 8 * q);
              o = MFMA16(sf, qf, o); }
          const int i = it * 16 + r, v0 = vt * 16 + 4 * q; const size_t row = row0 + i;
          if (KIND == 2) {
              const u32x2 zw = *(const u32x2*)(proj + row * LDP + h * 64 + vs * 32 + v0); const float z[4] = {bf_lo(zw.x), bf_hi(zw.x), bf_lo(zw.y), bf_hi(zw.y)};
#pragma unroll
              for (int ii = 0; ii < 4; ++ii) o[ii] = (o[ii] + Dh * XS[i * 32 + v0 + ii]) * siluf_(z[ii]);
          }
          u32x2 w; w.x = pk2(o[0], o[1]); w.y = pk2(o[2], o[3]);
          *(u32x2*)(mix + row * 1024 + h * V + vs * 32 + v0) = w;
        }
        if (wid < NKT) {
#pragma unroll
            for (int vt = 0; vt < 2; ++vt) { f32x4 d = (f32x4){0.f, 0.f, 0.f, 0.f};
#pragma unroll
                for (int s = 0; s < 2; ++s) { const int kr = wid * 16 + r, vr = vt * 16 + r;
                    const bf16x8 kf = *(const LAS bf16x8*)(KTT + kr * 72 + tsw(kr, 32 * s + 8 * q)); const bf16x8 vf = *(const LAS bf16x8*)(VT + vr * 72 + tsw(vr, 32 * s + 8 * q));
                    d = MFMA16(kf, vf, d); }
#pragma unroll
                for (int ii = 0; ii < 4; ++ii) { const int k = wid * 16 + 4 * q + ii; Sacc[vt][ii] = FD[k] * Sacc[vt][ii] + FC[k] * d[ii]; } }
        }
    }
}


template <int KIND>
DI void scan_pre(AP a, LAS unsigned char* lds, int item, bf16_t* proj, bf16_t* mix, float* fac, bool wrq = true) {
    constexpr int K = KIND == 0 ? 96 : 128;
    constexpr int V = KIND == 0 ? 192 : 128;
    constexpr int H = KIND == 0 ? 4 : 6;
    constexpr int KP = K + 8, K8 = K / 8, NST = K / 32, V8 = V / 8, NVT = V / 16;
    constexpr int LDP = KIND == 0 ? NPAD0 : NPAD3;
    const int tid = TID(), lane = tid & 63, wid = tid >> 6, r = lane & 15, q = lane >> 4;
    const int c = item & 127, h = (item >> 7) % H, b = item / (128 * H);
    constexpr int B_QT = 0, B_KT = B_QT + 64 * KP * 2, B_VT = B_KT + 64 * KP * 2, B_ATT = B_VT + V * 72 * 2, B_X = B_ATT + 64 * 72 * 2;
    LAS bf16_t* QT = (LAS bf16_t*)(lds + B_QT); LAS bf16_t* KT = (LAS bf16_t*)(lds + B_KT);
    LAS bf16_t* VT = (LAS bf16_t*)(lds + B_VT); LAS bf16_t* ATT = (LAS bf16_t*)(lds + B_ATT);
    LAS float* LA = (LAS float*)(lds + B_X); LAS float* BC = LA + 64 * K; LAS float* XT = BC + 64 * K;
    static_assert(B_X + (2 * 64 * K + 16 * 96 + 96 + 64 * 16) * 4 <= LDS_BYTES - 16, "scan_pre LDS");
    const size_t row0 = (size_t)b * SEQ + (size_t)c * 64;
    constexpr int QCOL = 0, KCOL = KIND == 0 ? 384 : 768, VCOL = KIND == 0 ? 768 : 1536;
    bar();
    if (KIND == 0) {
        const float* w2 = a->in[14]; const float* bg = a->in[15];
        for (int i = tid; i < 16 * 96; i += 512) XT[i] = w2[(i / 96) * 384 + h * 96 + (i % 96)];
        if (tid < 96) XT[16 * 96 + tid] = bg[h * 96 + tid];
        LAS float* GLR = XT + 16 * 96 + 96;
        if (tid < 128) { const int t = tid >> 1, hf = tid & 1; const u32x4 w = *(const u32x4*)(proj + (row0 + t) * LDP + 1536 + hf * 8); float f[8]; unpack8(w, f);
#pragma unroll
            for (int i = 0; i < 8; ++i) GLR[t * 16 + hf * 8 + i] = f[i]; }
    } else {
        const float* lbp = a->in[31];
        if (tid < 128) { const int cc = h * 128 + tid; const float v0 = lbp[cc], v1 = lbp[768 + cc], v2 = lbp[1536 + cc], v3 = lbp[2304 + cc];
            const float m = fmaxf(fmaxf(v0, v1), fmaxf(v2, v3)); const float e0 = __expf(v0 - m), e1 = __expf(v1 - m), e2 = __expf(v2 - m), e3 = __expf(v3 - m);
            XT[tid] = (e1 + e2 + e3) / (e0 + e1 + e2 + e3); }
    }
    u32x4 qw[2], kw[2];
#pragma unroll
    for (int p = 0; p < 2; ++p) { const int e = tid + 512 * p; qw[p] = (u32x4){0u, 0u, 0u, 0u}; kw[p] = qw[p];
        if (e < 64 * K8) { const int t = e / K8, k8 = (e % K8) * 8; const bf16_t* rp = proj + (row0 + t) * LDP + h * K + k8;
            qw[p] = *(const u32x4*)(rp + QCOL); kw[p] = *(const u32x4*)(rp + KCOL); } }
    for (int e = tid; e < 64 * V8; e += 512) { const int t = e / V8, v8 = (e % V8) * 8; const u32x4 vw = *(const u32x4*)(proj + (row0 + t) * LDP + VCOL + h * V + v8);
        const unsigned vv[4] = {vw.x, vw.y, vw.z, vw.w};
#pragma unroll
        for (int i = 0; i < 8; ++i) VT[(v8 + i) * 72 + tsw(v8 + i, t)] = (bf16_t)((i & 1) ? (vv[i >> 1] >> 16) : (vv[i >> 1] & 0xffffu)); }
    bar();
    float omf[2][8];
    if (KIND == 0) {
        LAS float* GLR = XT + 16 * 96 + 96;
#pragma unroll
        for (int p = 0; p < 2; ++p) { const int e = tid + 512 * p;
            if (e < 64 * K8) { const int t = e / K8, k8 = (e % K8) * 8; float acc8[8];
#pragma unroll
                for (int i = 0; i < 8; ++i) acc8[i] = XT[16 * 96 + k8 + i];
#pragma unroll
                for (int rr = 0; rr < 16; ++rr) { const float gv = GLR[t * 16 + rr];
#pragma unroll
                    for (int i = 0; i < 8; ++i) acc8[i] += gv * XT[rr * 96 + k8 + i]; }
#pragma unroll
                for (int i = 0; i < 8; ++i) { const float x = acc8[i]; LA[t * K + k8 + i] = (fminf(x, 0.f) - __logf(1.0f + __expf(-fabsf(x)))) * (1.0f / 16.0f); } } }
    } else {
#pragma unroll
        for (int p = 0; p < 2; ++p) { const int e = tid + 512 * p; const int t = e / K8, k8 = (e % K8) * 8; float f[8]; unpack8(kw[p], f);
#pragma unroll
            for (int i = 0; i < 8; ++i) { const float lb = XT[k8 + i]; const float fg = lb + (1.0f - lb) * sigmoidf_(f[i]); omf[p][i] = 1.0f - fg; LA[t * K + k8 + i] = __logf(fg); } }
    }
    bar();
    for (int it = tid; it < K * 8; it += 512) { const int k = it % K, seg = it / K; float pre = 0.f;
        for (int t = 0; t < seg * 8; ++t) pre += LA[t * K + k];
#pragma unroll
        for (int i = 0; i < 8; ++i) { pre += LA[(seg * 8 + i) * K + k]; BC[(seg * 8 + i) * K + k] = pre; } }
    bar();
#pragma unroll
    for (int p = 0; p < 2; ++p) { const int e = tid + 512 * p;
        if (e < 64 * K8) { const int t = e / K8, k8 = (e % K8) * 8; float qv[8], kv[8]; unpack8(qw[p], qv); unpack8(kw[p], kv);
#pragma unroll
            for (int i = 0; i < 8; ++i) { const float bb = BC[t * K + k8 + i], br = BC[31 * K + k8 + i]; const float ea = __expf(bb - br), eb = __expf(br - bb);
                if (KIND == 0) { qv[i] = qv[i] * 0.10206207261596575f * ea; kv[i] = kv[i] * eb; }
                else { qv[i] = siluf_(qv[i]) * ea; kv[i] = omf[p][i] * eb; } }
            const u32x4 qp = pack8(qv), kp = pack8(kv);
            *(LAS u32x4*)(QT + t * KP + k8) = qp; *(LAS u32x4*)(KT + t * KP + k8) = kp;
            bf16_t* rp = proj + (row0 + t) * LDP + h * K + k8;
            if (wrq) { *(u32x4*)(rp + QCOL) = qp; *(u32x4*)(rp + KCOL) = kp; } } }
    if (tid < K) { float* fp = fac + (size_t)item * 3 * K; const float b31 = BC[31 * K + tid], b63 = BC[63 * K + tid];
        fp[tid] = __expf(b31); fp[K + tid] = __expf(b63); fp[2 * K + tid] = __expf(b63 - b31); }
    bar();
    { const int it = wid >> 1;
#pragma unroll
      for (int jj = 0; jj < 2; ++jj) { const int jt = 2 * (wid & 1) + jj; f32x4 acc = (f32x4){0.f, 0.f, 0.f, 0.f};
#pragma unroll
          for (int s = 0; s < NST; ++s) { const bf16x8 kf = *(const LAS bf16x8*)(KT + (jt * 16 + r) * KP + 32 * s + 8 * q); const bf16x8 qf = *(const LAS bf16x8*)(QT + (it * 16 + r) * KP + 32 * s + 8 * q);
              acc = MFMA16(kf, qf, acc); }
          const int i = it * 16 + r;
#pragma unroll
          for (int ii = 0; ii < 4; ++ii) { const int j = jt * 16 + 4 * q + ii; acc[ii] = (j <= i) ? acc[ii] : 0.f; }
          u32x2 w; w.x = pk2(acc[0], acc[1]); w.y = pk2(acc[2], acc[3]); *(LAS u32x2*)(ATT + i * 72 + jt * 16 + 4 * q) = w; } }
    bar();
    { const int it = wid >> 1;
#pragma unroll
      for (int j = 0; j < NVT / 2; ++j) { const int vt = (wid & 1) + 2 * j; f32x4 o = (f32x4){0.f, 0.f, 0.f, 0.f};
#pragma unroll
          for (int s = 0; s < 2; ++s) { const int vr = vt * 16 + r; const bf16x8 vf = *(const LAS bf16x8*)(VT + vr * 72 + tsw(vr, 32 * s + 8 * q)); const bf16x8 af = *(const LAS bf16x8*)(ATT + (it * 16 + r) * 72 + 32 * s + 8 * q);
              o = MFMA16(vf, af, o); }
          u32x2 w; w.x = pk2(o[0], o[1]); w.y = pk2(o[2], o[3]);
          *(u32x2*)(mix + (row0 + it * 16 + r) * 1024 + h * V + vt * 16 + 4 * q) = w; } }
}

template <int KIND>
DI void scan_seq(AP a, LAS unsigned char* lds, int unit, const bf16_t* proj, bf16_t* mix, const float* fac) {
    constexpr int K = KIND == 0 ? 96 : 128;
    constexpr int V = KIND == 0 ? 192 : 128;
    constexpr int H = KIND == 0 ? 4 : 6;
    constexpr int NVS = V / 32, KP = K + 8, K8 = K / 8, NST = K / 32, NKT = K / 16;
    constexpr int LDP = KIND == 0 ? NPAD0 : NPAD3;
    const int tid = TID(), lane = tid & 63, wid = tid >> 6, r = lane & 15, q = lane >> 4;
    const int vs = unit % NVS, h = (unit / NVS) % H, b = unit / (NVS * H);
    constexpr int B_QT = 0, B_KTT = B_QT + 64 * KP * 2, B_VT = B_KTT + K * 72 * 2, B_ST = B_VT + 32 * 72 * 2;
    constexpr int SEQ_BUF = B_ST + 32 * KP * 2;
    LAS bf16_t* QT0 = (LAS bf16_t*)(lds + B_QT); LAS bf16_t* KTT0 = (LAS bf16_t*)(lds + B_KTT); LAS bf16_t* VT0 = (LAS bf16_t*)(lds + B_VT); LAS bf16_t* ST0 = (LAS bf16_t*)(lds + B_ST);
    constexpr int QCOL = 0, KCOL = KIND == 0 ? 384 : 768, VCOL = KIND == 0 ? 768 : 1536;
    const size_t rowb = (size_t)b * SEQ;
    const int it = wid >> 1, vt = wid & 1;
    const int item0 = (b * H + h) * 128;
    f32x4 Sacc[2]; Sacc[0] = (f32x4){0.f, 0.f, 0.f, 0.f}; Sacc[1] = Sacc[0];
    struct RS { u32x4 qw[2], kw[2], vw; u32x2 oi; f32x4 fe, fd, fc; };
    RS A, B;
#define SEQ_LOAD(R, cc) do { const size_t row0_ = rowb + (size_t)(cc) * 64; \
        _Pragma("unroll") for (int p = 0; p < 2; ++p) { const int e = tid + 512 * p; R.qw[p] = (u32x4){0u, 0u, 0u, 0u}; R.kw[p] = R.qw[p]; \
            if (e < 64 * K8) { const int t = e / K8, k8 = (e % K8) * 8; const bf16_t* rp = proj + (row0_ + t) * LDP + h * K + k8; R.qw[p] = *(const u32x4*)(rp + QCOL); R.kw[p] = *(const u32x4*)(rp + KCOL); } } \
        R.vw = (u32x4){0u, 0u, 0u, 0u}; if (tid < 256) R.vw = *(const u32x4*)(proj + (row0_ + (tid >> 2)) * LDP + VCOL + h * V + vs * 32 + (tid & 3) * 8); \
        R.oi = *(const u32x2*)(mix + (row0_ + it * 16 + r) * 1024 + h * V + vs * 32 + vt * 16 + 4 * q); \
        R.fe = (f32x4){0.f, 0.f, 0.f, 0.f}; R.fd = R.fe; R.fc = R.fe; \
        if (wid < NKT) { const float* fp = fac + (size_t)(item0 + (cc)) * 3 * K + wid * 16 + 4 * q; R.fe = *(const f32x4*)fp; R.fd = *(const f32x4*)(fp + K); R.fc = *(const f32x4*)(fp + 2 * K); } } while (0)
#define SEQ_BODY(R, c, PB) do { \
        LAS bf16_t* QT = QT0 + (PB) * (SEQ_BUF / 2); LAS bf16_t* KTT = KTT0 + (PB) * (SEQ_BUF / 2); LAS bf16_t* VT = VT0 + (PB) * (SEQ_BUF / 2); LAS bf16_t* ST = ST0 + (PB) * (SEQ_BUF / 2); \
        const size_t row0 = rowb + (size_t)(c) * 64; \
        _Pragma("unroll") for (int p = 0; p < 2; ++p) { const int e = tid + 512 * p; \
            if (e < 64 * K8) { const int t = e / K8, k8 = (e % K8) * 8; *(LAS u32x4*)(QT + t * KP + k8) = R.qw[p]; \
                const unsigned kk[4] = {R.kw[p].x, R.kw[p].y, R.kw[p].z, R.kw[p].w}; \
                _Pragma("unroll") for (int i = 0; i < 8; ++i) KTT[(k8 + i) * 72 + tsw(k8 + i, t)] = (bf16_t)((i & 1) ? (kk[i >> 1] >> 16) : (kk[i >> 1] & 0xffffu)); } } \
        if (tid < 256) { const int t = tid >> 2, v8 = (tid & 3) * 8; const unsigned vv[4] = {R.vw.x, R.vw.y, R.vw.z, R.vw.w}; \
            _Pragma("unroll") for (int i = 0; i < 8; ++i) VT[(v8 + i) * 72 + tsw(v8 + i, t)] = (bf16_t)((i & 1) ? (vv[i >> 1] >> 16) : (vv[i >> 1] & 0xffffu)); } \
        if (wid < NKT) { \
            _Pragma("unroll") for (int v2 = 0; v2 < 2; ++v2) { const int k0 = wid * 16 + q * 4; u32x2 w; w.x = pk2(Sacc[v2][0] * R.fe[0], Sacc[v2][1] * R.fe[1]); w.y = pk2(Sacc[v2][2] * R.fe[2], Sacc[v2][3] * R.fe[3]); \
                *(LAS u32x2*)(ST + (v2 * 16 + r) * KP + k0) = w; } } \
        const f32x4 cfd = R.fd, cfc = R.fc; const u32x2 coi = R.oi; \
        bar_l(); \
        if ((c) + 2 < SEQ / 64) SEQ_LOAD(R, (c) + 2); \
        { f32x4 o; o[0] = bf_lo(coi.x); o[1] = bf_hi(coi.x); o[2] = bf_lo(coi.y); o[3] = bf_hi(coi.y); \
          _Pragma("unroll") for (int s = 0; s < NST; ++s) { const bf16x8 sf = *(const LAS bf16x8*)(ST + (vt * 16 + r) * KP + 32 * s + 8 * q); const bf16x8 qf = *(const LAS bf16x8*)(QT + (it * 16 + r) * KP + 32 * s + 8 * q); \
              o = MFMA16(sf, qf, o); } \
          u32x2 w; w.x = pk2(o[0], o[1]); w.y = pk2(o[2], o[3]); \
          *(u32x2*)(mix + (row0 + it * 16 + r) * 1024 + h * V + vs * 32 + vt * 16 + 4 * q) = w; } \
        if (wid < NKT) { \
            _Pragma("unroll") for (int v2 = 0; v2 < 2; ++v2) { f32x4 d = (f32x4){0.f, 0.f, 0.f, 0.f}; \
                _Pragma("unroll") for (int s = 0; s < 2; ++s) { const int kr = wid * 16 + r, vr = v2 * 16 + r; \
                    const bf16x8 kf = *(const LAS bf16x8*)(KTT + kr * 72 + tsw(kr, 32 * s + 8 * q)); const bf16x8 vf = *(const LAS bf16x8*)(VT + vr * 72 + tsw(vr, 32 * s + 8 * q)); \
                    d = MFMA16(kf, vf, d); } \
                _Pragma("unroll") for (int ii = 0; ii < 4; ++ii) Sacc[v2][ii] = cfd[ii] * Sacc[v2][ii] + cfc[ii] * d[ii]; } \
        } } while (0)
    bar();
    SEQ_LOAD(A, 0); SEQ_LOAD(B, 1);
    for (int c = 0; c < SEQ / 64; c += 2) { SEQ_BODY(A, c, 0); SEQ_BODY(B, c + 1, 1); }
#undef SEQ_LOAD
#undef SEQ_BODY
}


DI void ssd_pre(AP a, LAS unsigned char* lds, int item, const bf16_t* proj, bf16_t* mix, bf16_t* cbg, bf16_t* xdt, float* acsg) {
    constexpr int LDP = NPAD2, KP = 136;
    const int tid = TID(), lane = tid & 63, wid = tid >> 6, r = lane & 15, q = lane >> 4;
    const int c = item & 127, g = (item >> 7) & 1, b = item >> 8;
    constexpr int B_RAW = 0, B_CW = 67 * 640 * 2, B_CB = B_CW + 4 * 640 * 4, B_QT = B_CB + 640 * 4, B_KT = B_QT + 64 * KP * 2, B_VT = B_KT + 64 * KP * 2,
                  B_ATT = B_VT + 64 * 72 * 2, B_ACS = B_ATT + 64 * 72 * 2, B_DTS = B_ACS + 6 * 64 * 4, B_END = B_DTS + 6 * 64 * 4;
    static_assert(B_END <= LDS_BYTES - 32, "ssd_pre LDS");
    LAS bf16_t* RAW = (LAS bf16_t*)(lds + B_RAW); LAS float* CW = (LAS float*)(lds + B_CW); LAS float* CBs = (LAS float*)(lds + B_CB);
    LAS bf16_t* QT = (LAS bf16_t*)(lds + B_QT); LAS bf16_t* KT = (LAS bf16_t*)(lds + B_KT); LAS bf16_t* VT = (LAS bf16_t*)(lds + B_VT); LAS bf16_t* ATT = (LAS bf16_t*)(lds + B_ATT);
    LAS float* ACS = (LAS float*)(lds + B_ACS); LAS float* DTS = (LAS float*)(lds + B_DTS);
    const size_t rowb = (size_t)b * SEQ, row0 = rowb + (size_t)c * 64;
    bar();
    { const float* cw = a->in[23]; const float* cb = a->in[24];
      for (int i = tid; i < 640; i += 512) { const int ch = i < 384 ? g * 384 + i : (i < 512 ? 768 + g * 128 + (i - 384) : 1024 + g * 128 + (i - 512));
#pragma unroll
          for (int j = 0; j < 4; ++j) CW[j * 640 + i] = cw[j * 1280 + ch];
          CBs[i] = cb[ch]; } }
    for (int e = tid; e < 67 * 80; e += 512) { const int rw = e / 80, cv = e % 80; const long t = (long)c * 64 + rw - 3;
        const int col = cv < 48 ? 768 + g * 384 + cv * 8 : (cv < 64 ? 1536 + g * 128 + (cv - 48) * 8 : 1792 + g * 128 + (cv - 64) * 8);
        u32x4 w = (u32x4){0u, 0u, 0u, 0u}; if (t >= 0) w = *(const u32x4*)(proj + (rowb + t) * LDP + col);
        *(LAS u32x4*)(RAW + rw * 640 + cv * 8) = w; }
    if (wid < 6) { const int head = g * 6 + wid; const float dr = bf2f(proj[(row0 + lane) * LDP + 2304 + head]) + a->in[25][head]; const float dt = dr > 20.f ? dr : __logf(1.0f + __expf(dr));
        float cs = dt * (-__expf(a->in[26][head]));
#pragma unroll
        for (int o = 1; o < 64; o <<= 1) { const float n = __shfl_up(cs, o); if (lane >= o) cs += n; }
        ACS[wid * 64 + lane] = cs; DTS[wid * 64 + lane] = dt; acsg[(row0 + lane) * 12 + head] = cs; }
    bar();
    for (int e = tid; e < 64 * 32; e += 512) { const int t = e >> 5, cv = 48 + (e & 31); float val[8];
#pragma unroll
        for (int i = 0; i < 8; ++i) val[i] = CBs[cv * 8 + i];
#pragma unroll
        for (int j = 0; j < 4; ++j) { float f[8]; unpack8(*(const LAS u32x4*)(RAW + (t + j) * 640 + cv * 8), f);
#pragma unroll
            for (int i = 0; i < 8; ++i) val[i] += CW[j * 640 + cv * 8 + i] * f[i]; }
#pragma unroll
        for (int i = 0; i < 8; ++i) val[i] = siluf_(val[i]);
        const u32x4 w = pack8(val);
        if (cv < 64) { const int k8 = (cv - 48) * 8; *(LAS u32x4*)(KT + t * KP + k8) = w; *(u32x4*)(cbg + (row0 + t) * 512 + g * 256 + 128 + k8) = w; }
        else { const int k8 = (cv - 64) * 8; *(LAS u32x4*)(QT + t * KP + k8) = w; *(u32x4*)(cbg + (row0 + t) * 512 + g * 256 + k8) = w; } }
    bar();
    const int it = wid >> 1;
    f32x4 cbt[2];
#pragma unroll
    for (int jj = 0; jj < 2; ++jj) { const int jt = 2 * (wid & 1) + jj; cbt[jj] = (f32x4){0.f, 0.f, 0.f, 0.f};
#pragma unroll
        for (int s = 0; s < 4; ++s) { const bf16x8 kf = *(const LAS bf16x8*)(KT + (jt * 16 + r) * KP + 32 * s + 8 * q); const bf16x8 qf = *(const LAS bf16x8*)(QT + (it * 16 + r) * KP + 32 * s + 8 * q);
            cbt[jj] = MFMA16(kf, qf, cbt[jj]); } }
    for (int hh = 0; hh < 6; ++hh) {
        const int head = g * 6 + hh;
        const float Dh = a->in[27][head];
        bar();
        { const int t = tid >> 3, p8 = (tid & 7) * 8, cv = hh * 8 + (tid & 7); float val[8];
#pragma unroll
          for (int i = 0; i < 8; ++i) val[i] = CBs[cv * 8 + i];
#pragma unroll
          for (int j = 0; j < 4; ++j) { float f[8]; unpack8(*(const LAS u32x4*)(RAW + (t + j) * 640 + cv * 8), f);
#pragma unroll
              for (int i = 0; i < 8; ++i) val[i] += CW[j * 640 + cv * 8 + i] * f[i]; }
          const float dt = DTS[hh * 64 + t];
#pragma unroll
          for (int i = 0; i < 8; ++i) val[i] = siluf_(val[i]) * dt;
          const u32x4 w = pack8(val);
          *(u32x4*)(xdt + (row0 + t) * 768 + head * 64 + p8) = w;
          const unsigned vv[4] = {w.x, w.y, w.z, w.w};
#pragma unroll
          for (int i = 0; i < 8; ++i) VT[(p8 + i) * 72 + tsw(p8 + i, t)] = (bf16_t)((i & 1) ? (vv[i >> 1] >> 16) : (vv[i >> 1] & 0xffffu)); }
        { const int i = it * 16 + r; const float ai = ACS[hh * 64 + i];
#pragma unroll
          for (int jj = 0; jj < 2; ++jj) { const int jt = 2 * (wid & 1) + jj; float v4[4];
#pragma unroll
              for (int ii = 0; ii < 4; ++ii) { const int j = jt * 16 + 4 * q + ii; float v = (j <= i) ? cbt[jj][ii] * __expf(ai - ACS[hh * 64 + j]) : 0.f;
                  if (j == i) v += Dh * __builtin_amdgcn_rcpf(DTS[hh * 64 + i]);
                  v4[ii] = v; }
              u32x2 w; w.x = pk2(v4[0], v4[1]); w.y = pk2(v4[2], v4[3]); *(LAS u32x2*)(ATT + i * 72 + jt * 16 + 4 * q) = w; } }
        bar();
#pragma unroll
        for (int j = 0; j < 2; ++j) { const int vt = (wid & 1) + 2 * j; f32x4 o = (f32x4){0.f, 0.f, 0.f, 0.f};
#pragma unroll
            for (int s = 0; s < 2; ++s) { const int vr = vt * 16 + r; const bf16x8 vf = *(const LAS bf16x8*)(VT + vr * 72 + tsw(vr, 32 * s + 8 * q)); const bf16x8 af = *(const LAS bf16x8*)(ATT + (it * 16 + r) * 72 + 32 * s + 8 * q);
                o = MFMA16(vf, af, o); }
            u32x2 w; w.x = pk2(o[0], o[1]); w.y = pk2(o[2], o[3]);
            *(u32x2*)(mix + (row0 + it * 16 + r) * 1024 + head * 64 + vt * 16 + 4 * q) = w; }
    }
}

DI void ssd_seq(AP a, LAS unsigned char* lds, int unit, const bf16_t* proj, bf16_t* mix, const bf16_t* cbg, const bf16_t* xdt, const float* acsg) {
    constexpr int K = 128, KP = 136, LDP = NPAD2;
    const int tid = TID(), lane = tid & 63, wid = tid >> 6, r = lane & 15, q = lane >> 4;
    const int vs = unit & 1, head = (unit >> 1) % 12, b = unit / 24, g = head / 6;
    constexpr int B_QT = 0, B_KTT = B_QT + 64 * KP * 2, B_VT = B_KTT + K * 72 * 2, B_ST = B_VT + 32 * 72 * 2;
    constexpr int SEQ_BUF = B_ST + 32 * KP * 2;
    LAS bf16_t* QT0 = (LAS bf16_t*)(lds + B_QT); LAS bf16_t* KTT0 = (LAS bf16_t*)(lds + B_KTT); LAS bf16_t* VT0 = (LAS bf16_t*)(lds + B_VT); LAS bf16_t* ST0 = (LAS bf16_t*)(lds + B_ST);
    const size_t rowb = (size_t)b * SEQ;
    const int it = wid >> 1, vt = wid & 1;
    f32x4 Sacc[2]; Sacc[0] = (f32x4){0.f, 0.f, 0.f, 0.f}; Sacc[1] = Sacc[0];
    struct RS { u32x4 qw[2], kw[2], vw; u32x2 oi, zw; float a0, a1, al; };
    RS A, B;
#define SSD_LOAD(R, cc) do { const size_t row0_ = rowb + (size_t)(cc) * 64; \
        _Pragma("unroll") for (int p = 0; p < 2; ++p) { const int e = tid + 512 * p; const int t = e >> 4, k8 = (e & 15) * 8; const bf16_t* rp = cbg + (row0_ + t) * 512 + g * 256 + k8; R.qw[p] = *(const u32x4*)rp; R.kw[p] = *(const u32x4*)(rp + 128); } \
        R.vw = (u32x4){0u, 0u, 0u, 0u}; if (tid < 256) R.vw = *(const u32x4*)(xdt + (row0_ + (tid >> 2)) * 768 + head * 64 + vs * 32 + (tid & 3) * 8); \
        R.oi = *(const u32x2*)(mix + (row0_ + it * 16 + r) * 1024 + head * 64 + vs * 32 + vt * 16 + 4 * q); \
        R.zw = *(const u32x2*)(proj + (row0_ + it * 16 + r) * LDP + head * 64 + vs * 32 + vt * 16 + 4 * q); \
        R.a0 = acsg[(row0_ + (tid >> 4)) * 12 + head]; R.a1 = acsg[(row0_ + 32 + (tid >> 4)) * 12 + head]; R.al = acsg[(row0_ + 63) * 12 + head]; } while (0)
#define SSD_BODY(R, c, PB) do { \
        LAS bf16_t* QT = QT0 + (PB) * (SEQ_BUF / 2); LAS bf16_t* KTT = KTT0 + (PB) * (SEQ_BUF / 2); LAS bf16_t* VT = VT0 + (PB) * (SEQ_BUF / 2); LAS bf16_t* ST = ST0 + (PB) * (SEQ_BUF / 2); \
        const size_t row0 = rowb + (size_t)(c) * 64; \
        _Pragma("unroll") for (int p = 0; p < 2; ++p) { const int e = tid + 512 * p; const int t = e >> 4, k8 = (e & 15) * 8; const float at = p == 0 ? R.a0 : R.a1; \
            const float e1 = __expf(at), e2 = __expf(R.al - at); float cf[8], bfv[8]; unpack8(R.qw[p], cf); unpack8(R.kw[p], bfv); \
            _Pragma("unroll") for (int i = 0; i < 8; ++i) { cf[i] *= e1; bfv[i] *= e2; } \
            *(LAS u32x4*)(QT + t * KP + k8) = pack8(cf); const u32x4 kp = pack8(bfv); const unsigned kk[4] = {kp.x, kp.y, kp.z, kp.w}; \
            _Pragma("unroll") for (int i = 0; i < 8; ++i) KTT[(k8 + i) * 72 + tsw(k8 + i, t)] = (bf16_t)((i & 1) ? (kk[i >> 1] >> 16) : (kk[i >> 1] & 0xffffu)); } \
        if (tid < 256) { const int t = tid >> 2, v8 = (tid & 3) * 8; const unsigned vv[4] = {R.vw.x, R.vw.y, R.vw.z, R.vw.w}; \
            _Pragma("unroll") for (int i = 0; i < 8; ++i) VT[(v8 + i) * 72 + tsw(v8 + i, t)] = (bf16_t)((i & 1) ? (vv[i >> 1] >> 16) : (vv[i >> 1] & 0xffffu)); } \
        _Pragma("unroll") for (int v2 = 0; v2 < 2; ++v2) { const int k0 = wid * 16 + q * 4; u32x2 w; w.x = pk2(Sacc[v2][0], Sacc[v2][1]); w.y = pk2(Sacc[v2][2], Sacc[v2][3]); \
            *(LAS u32x2*)(ST + (v2 * 16 + r) * KP + k0) = w; } \
        const float dec = __expf(R.al); const u32x2 coi = R.oi, czw = R.zw; \
        bar_l(); \
        if ((c) + 2 < SEQ / 64) SSD_LOAD(R, (c) + 2); \
        { f32x4 o; o[0] = bf_lo(coi.x); o[1] = bf_hi(coi.x); o[2] = bf_lo(coi.y); o[3] = bf_hi(coi.y); \
          _Pragma("unroll") for (int s = 0; s < 4; ++s) { const bf16x8 sf = *(const LAS bf16x8*)(ST + (vt * 16 + r) * KP + 32 * s + 8 * q); const bf16x8 qf = *(const LAS bf16x8*)(QT + (it * 16 + r) * KP + 32 * s + 8 * q); \
              o = MFMA16(sf, qf, o); } \
          o[0] *= siluf_(bf_lo(czw.x)); o[1] *= siluf_(bf_hi(czw.x)); o[2] *= siluf_(bf_lo(czw.y)); o[3] *= siluf_(bf_hi(czw.y)); \
          u32x2 w; w.x = pk2(o[0], o[1]); w.y = pk2(o[2], o[3]); \
          *(u32x2*)(mix + (row0 + it * 16 + r) * 1024 + head * 64 + vs * 32 + vt * 16 + 4 * q) = w; } \
        _Pragma("unroll") for (int v2 = 0; v2 < 2; ++v2) { f32x4 d = (f32x4){0.f, 0.f, 0.f, 0.f}; \
            _Pragma("unroll") for (int s = 0; s < 2; ++s) { const int kr = wid * 16 + r, vr = v2 * 16 + r; \
                const bf16x8 kf = *(const LAS bf16x8*)(KTT + kr * 72 + tsw(kr, 32 * s + 8 * q)); const bf16x8 vf = *(const LAS bf16x8*)(VT + vr * 72 + tsw(vr, 32 * s + 8 * q)); \
                d = MFMA16(kf, vf, d); } \
            _Pragma("unroll") for (int ii = 0; ii < 4; ++ii) Sacc[v2][ii] = dec * Sacc[v2][ii] + d[ii]; } } while (0)
    bar();
    SSD_LOAD(A, 0); SSD_LOAD(B, 1);
    for (int c = 0; c < SEQ / 64; c += 2) { SSD_BODY(A, c, 0); SSD_BODY(B, c + 1, 1); }
#undef SSD_LOAD
#undef SSD_BODY
}

DI void post_pass(AP a, int layer, const bf16_t* proj, bf16_t* mix) {
    const int lane = TID() & 63, wid = TID() >> 6;
    for (int row = BID() * 8 + wid; row < NTOK; row += GDIM() * 8) {
        if (layer == 1) {
            if (((row - BID() * 8 - wid) / (GDIM() * 8)) & 1) continue;
            const float* lse = (const float*)(a->ws + O_LSE);
            const int hh = lane >> 4, d8 = (lane & 15) * 8;
            u32x4 v[2][3]; float lv[2][3]; int rows[2]; bool ok[2];
#pragma unroll
            for (int u = 0; u < 2; ++u) { rows[u] = row + u * GDIM() * 8; ok[u] = rows[u] < NTOK; const int ru = ok[u] ? rows[u] : row;
#pragma unroll
                for (int g = 0; g < 3; ++g) { lv[u][g] = lse[((size_t)g * NTOK + ru) * 4 + hh]; v[u][g] = *(const u32x4*)(proj + (size_t)ru * 4864 + (g * 4 + hh) * 128 + d8); } }
#pragma unroll
            for (int u = 0; u < 2; ++u) {
                if (!ok[u]) continue;
                const float m = fmaxf(lv[u][0], fmaxf(lv[u][1], lv[u][2])); const float e0 = __expf(lv[u][0] - m), e1 = __expf(lv[u][1] - m), e2 = __expf(lv[u][2] - m); const float inv = 1.0f / (e0 + e1 + e2);
                const float w[3] = {e0 * inv, e1 * inv, e2 * inv};
                float o[8] = {0.f, 0.f, 0.f, 0.f, 0.f, 0.f, 0.f, 0.f};
#pragma unroll
                for (int g = 0; g < 3; ++g) { float f[8]; unpack8(v[u][g], f);
#pragma unroll
                    for (int i = 0; i < 8; ++i) o[i] += w[g] * f[i]; }
                *(u32x4*)(mix + (size_t)rows[u] * 768 + hh * 128 + d8) = pack8(o);
            }
        } else {
            if (((row - BID() * 8 - wid) / (GDIM() * 8)) & 1) continue;
            u32x4 mw[2][2], gw[2][2]; int rows[2]; bool ok[2];
#pragma unroll
            for (int u = 0; u < 2; ++u) { rows[u] = row + u * GDIM() * 8; ok[u] = rows[u] < NTOK; const int ru = ok[u] ? rows[u] : row;
                const bf16_t* mp = mix + (size_t)ru * 1024;
                mw[u][0] = *(const u32x4*)(mp + lane * 8); mw[u][1] = (u32x4){0u, 0u, 0u, 0u}; gw[u][0] = mw[u][1]; gw[u][1] = mw[u][1];
                if (lane < 32) mw[u][1] = *(const u32x4*)(mp + (lane + 64) * 8);
                if (layer != 2) { const bf16_t* gp = layer == 0 ? proj + (size_t)ru * NPAD0 + 1552 : proj + (size_t)ru * NPAD3 + 2304;
                    gw[u][0] = *(const u32x4*)(gp + lane * 8); if (lane < 32) gw[u][1] = *(const u32x4*)(gp + (lane + 64) * 8); } }
            const int GW = layer == 0 ? 24 : (layer == 2 ? 48 : 16);
            const int NG = 96 / GW;
            const int g0 = lane / GW, g1 = (lane + 64) / GW;
#pragma unroll
            for (int u = 0; u < 2; ++u) {
                if (!ok[u]) continue;
                float f0[8], f1[8]; unpack8(mw[u][0], f0); unpack8(mw[u][1], f1);
                float q0 = 0.f, q1 = 0.f;
#pragma unroll
                for (int i = 0; i < 8; ++i) { q0 += f0[i] * f0[i]; q1 += f1[i] * f1[i]; }
                float sc0 = 0.f, sc1 = 0.f;
                for (int g = 0; g < NG; ++g) {
                    const float t = wave_sum((g0 == g ? q0 : 0.f) + ((lane < 32 && g1 == g) ? q1 : 0.f));
                    const float sc = rsqrtf(t / (float)(GW * 8) + EPS);
                    if (g0 == g) sc0 = sc; if (g1 == g) sc1 = sc;
                }
                bf16_t* mp = mix + (size_t)rows[u] * 1024;
#pragma unroll
                for (int p = 0; p < 2; ++p) {
                    if (p == 1 && lane >= 32) break;
                    const int c8 = (p == 0 ? lane : lane + 64) * 8; const float sc = p == 0 ? sc0 : sc1; float* f = p == 0 ? f0 : f1;
                    float g[8]; unpack8(gw[u][p], g);
                    if (layer == 0) {
#pragma unroll
                        for (int i = 0; i < 8; ++i) f[i] = f[i] * sc * a->in[16][(c8 + i) % 192] * siluf_(g[i]); }
                    else if (layer == 2) {
#pragma unroll
                        for (int i = 0; i < 8; ++i) f[i] = f[i] * sc * a->in[28][c8 + i]; }
                    else {
#pragma unroll
                        for (int i = 0; i < 8; ++i) f[i] = f[i] * sc * a->in[32][(c8 + i) % 128] * sigmoidf_(g[i]); }
                    *(u32x4*)(mp + c8) = pack8(f);
                }
            }
        }
    }
}

DI void act_pass(AP a, int layer, int half) {
    const bf16_t* U = (const bf16_t*)(a->ws + O_BIG); bf16_t* ACT = (bf16_t*)(a->ws + O_ACTB);
    const float* cw = a->in[10] + (size_t)layer * 3 * 5632; const float* cb = a->in[11] + (size_t)layer * 5632;
    const size_t nitem = (size_t)(32768 / 32) * 352;
    for (size_t it = (size_t)BID() * 512 + TID(); it < nitem; it += (size_t)GDIM() * 512) {
        const int cg8 = (int)(it % 352) * 8, run = 1023 - (int)(it / 352); const int r0 = run * 32;
        float wg[3][8], wv[3][8], bgv[8], bvv[8];
#pragma unroll
        for (int i = 0; i < 8; ++i) { bgv[i] = cb[cg8 + i]; bvv[i] = cb[2816 + cg8 + i];
#pragma unroll
            for (int j = 0; j < 3; ++j) { wg[j][i] = cw[j * 5632 + cg8 + i]; wv[j][i] = cw[j * 5632 + 2816 + cg8 + i]; } }
        float g1[8], g2[8], v1[8], v2[8];
        const bool first = (r0 % SEQ) == 0;
        if (first) {
#pragma unroll
            for (int i = 0; i < 8; ++i) { g1[i] = g2[i] = v1[i] = v2[i] = 0.f; }
        } else {
            unpack8(*(const u32x4*)(U + (size_t)(r0 - 1) * 5632 + cg8), g1); unpack8(*(const u32x4*)(U + (size_t)(r0 - 2) * 5632 + cg8), g2);
            unpack8(*(const u32x4*)(U + (size_t)(r0 - 1) * 5632 + 2816 + cg8), v1); unpack8(*(const u32x4*)(U + (size_t)(r0 - 2) * 5632 + 2816 + cg8), v2);
        }
        for (int tb = 0; tb < 32; tb += 8) {
            u32x4 gw[8], vw8[8];
#pragma unroll
            for (int u = 0; u < 8; ++u) { gw[u] = *(const u32x4*)(U + (size_t)(r0 + tb + u) * 5632 + cg8); vw8[u] = *(const u32x4*)(U + (size_t)(r0 + tb + u) * 5632 + 2816 + cg8); }
#pragma unroll
            for (int u = 0; u < 8; ++u) {
                float g0[8], v0[8], o[8];
                unpack8(gw[u], g0); unpack8(vw8[u], v0);
#pragma unroll
                for (int i = 0; i < 8; ++i) { const float gg = bgv[i] + wg[0][i] * g2[i] + wg[1][i] * g1[i] + wg[2][i] * g0[i]; const float vv = bvv[i] + wv[0][i] * v2[i] + wv[1][i] * v1[i] + wv[2][i] * v0[i];
                    o[i] = siluf_(gg) * vv; g2[i] = g1[i]; g1[i] = g0[i]; v2[i] = v1[i]; v1[i] = v0[i]; }
                *(u32x4*)(ACT + (size_t)(r0 + tb + u) * 2816 + cg8) = pack8(o);
            }
        }
    }
    (void)half;
}


#define XB_TMO      128
#define XB_XCNT(j)  (256  + 64 * (j))
#define XB_XSUB(j)  (1280 + 64 * (j))
#define XB_XGEN(j)  (2304 + 64 * (j))
#define XB_TOP      3328
#define XB_TOPGEN   3392
#define XCD_BAR_WORDS 3456
#define XB_SPIN_CAP (1u << 18)
DI unsigned xb_ld(unsigned* p)              { return __hip_atomic_load(p, __ATOMIC_RELAXED, __HIP_MEMORY_SCOPE_AGENT); }
DI unsigned xb_add(unsigned* p, unsigned v) { return __hip_atomic_fetch_add(p, v, __ATOMIC_RELAXED, __HIP_MEMORY_SCOPE_AGENT); }
DI unsigned xb_xcc_id() { return (unsigned)__builtin_amdgcn_s_getreg((3 << 11) | 20) & 0xFu; }
#define XB_SPIN(cond, bar) do { unsigned _sp = 0; while (cond) { __builtin_amdgcn_s_sleep(1); \
    if ((++_sp & 255u) == 0u) { if (xb_ld(&(bar)[XB_TMO])) break; if (_sp > XB_SPIN_CAP) { atomicAdd(&(bar)[XB_TMO], 1u); break; } } } } while (0)
DI void xcd_barrier_complete(unsigned* bar, unsigned x, unsigned& nloc, unsigned& nx) {
    const unsigned G = gridDim.x;
    unsigned sum, cnt, mine, sp = 0u;
    for (;;) {
        sum = 0u; cnt = 0u; mine = 0u;
#pragma unroll
        for (unsigned j = 0; j < 16; ++j) { const unsigned c = xb_ld(&bar[XB_XCNT(j)]); sum += c; cnt += (c > 0u) ? 1u : 0u; mine = (j == x) ? c : mine; }
        if (sum == G) break;
        __builtin_amdgcn_s_sleep(1);
        if ((++sp & 255u) == 0u) { if (xb_ld(&bar[XB_TMO])) break; if (sp > XB_SPIN_CAP) { atomicAdd(&bar[XB_TMO], 1u); break; } }
    }
    nloc = mine > 0u ? mine : 1u; nx = cnt > 0u ? cnt : 1u;
}
DI void xcd_barrier(unsigned* bar, volatile LAS unsigned* st) {
    asm volatile("s_waitcnt vmcnt(0)" ::: "memory");
    __syncthreads();
    if (threadIdx.x == 0) {
        const unsigned x = xb_xcc_id();
        __builtin_amdgcn_s_waitcnt(0);
        unsigned nloc = st[0], nx = st[1];
        if (nloc == 0u) { xcd_barrier_complete(bar, x, nloc, nx); st[0] = nloc; st[1] = nx; }
        const unsigned old = xb_add(&bar[XB_XSUB(x)], 1u);
        const unsigned gen = old / nloc;
        if (old + 1u == (gen + 1u) * nloc) {
            __builtin_amdgcn_fence(__ATOMIC_RELEASE, "agent");
            asm volatile("s_waitcnt vmcnt(0)" ::: "memory");
            const unsigned og = xb_add(&bar[XB_TOP], 1u);
            const unsigned tg = og / nx;
            if (og + 1u == (tg + 1u) * nx) xb_add(&bar[XB_TOPGEN], 1u);
            else XB_SPIN(xb_ld(&bar[XB_TOPGEN]) == tg, bar);
            __builtin_amdgcn_fence(__ATOMIC_ACQUIRE, "agent");
            xb_add(&bar[XB_XGEN(x)], 1u);
            asm volatile("s_waitcnt vmcnt(0)" ::: "memory");
        } else {
            XB_SPIN(xb_ld(&bar[XB_XGEN(x)]) == gen, bar);
            __builtin_amdgcn_fence(__ATOMIC_ACQUIRE, "agent");
            asm volatile("s_waitcnt vmcnt(0)" ::: "memory");
        }
    }
    __syncthreads();
}

#ifndef EN
#define EN 1023
#endif
#ifndef EN2
#define EN2 3
#endif
constexpr int NPHASE = 2 + 4 * 10;
__global__ void __launch_bounds__(512) fwd_kernel(Args karg) {
    __shared__ __attribute__((aligned(16))) unsigned char smem[LDS_BYTES];
    LAS unsigned char* lds = (LAS unsigned char*)smem;
    const int ph_lo = karg.ph_lo, ph_hi = karg.ph_hi;
    { volatile LAS unsigned* st0 = (volatile LAS unsigned*)(lds + LDS_BYTES - 32); if (threadIdx.x < 2) st0[threadIdx.x] = 0u; __syncthreads();
      if (threadIdx.x == 0) (void)xb_add(&((unsigned*)(karg.ws + O_XBAR))[XB_XCNT(xb_xcc_id())], 1u); }
#ifdef DIAG_ZERO
    for (int i = threadIdx.x; i < LDS_BYTES / 4; i += 512) ((LAS unsigned*)lds)[i] = 0u;
    __syncthreads();
#endif
    for (int ph = ph_lo; ph < ph_hi; ++ph) {
        AP a = (AP)__builtin_amdgcn_kernarg_segment_ptr(); asm volatile("" : "+s"(a));
        unsigned char* ws = a->ws;
        const int tid = TID();
        pg8::Gemm gs{}, gr{}; pg8::EpiScale es{}; pg8::EpiResid er{}; bool dos = false, dor = false, skip = false;
        bf16_t* XB = (bf16_t*)(ws + O_XB); float* SSp = (float*)(ws + O_SS);
        if (ph == 0) { for (int rep_ = 0; rep_ < DUP_P; ++rep_) prologue(a, lds); }
        else if (ph == 1) { skip = true; }
        else {
            const int l = (ph - 2) / 10, s = (ph - 2) % 10;
            const int np = l == 0 ? NPAD0 : (l == 1 ? NPAD1 : (l == 2 ? NPAD2 : NPAD3));
            bf16_t* proj = (bf16_t*)(ws + O_BIG); bf16_t* mix = proj + (size_t)NTOK * np;
            const int kout = l == 1 ? 768 : 1024;
            const size_t owin = l == 0 ? O_WIN0 : (l == 1 ? O_WIN1 : (l == 2 ? O_WIN2 : O_WIN3)), owout = l == 0 ? O_WOUT0 : (l == 1 ? O_WOUT1 : (l == 2 ? O_WOUT2 : O_WOUT3));
            unsigned* ctr = (unsigned*)(ws + O_CTR) + l * 64;
            LAS unsigned* bc = (LAS unsigned*)(lds + LDS_BYTES - 16);
            float* fac = (float*)(ws + O_FAC);
            bf16_t* cbg = (bf16_t*)(ws + O_BIG + (size_t)469762048); bf16_t* xdtb = (bf16_t*)(ws + O_BIG + (size_t)536870912); float* acsg = (float*)(ws + O_BIG + (size_t)637534208);
            const int xqcol = l == 0 ? 2320 : (l == 1 ? 4608 : (l == 2 ? 2048 : 3072));
            if (s == 2 && l == 1) skip = true;
            else if (s == 0) { gs.A = XB; gs.Bt = (const bf16_t*)(ws + owin); gs.M = NTOK; gs.N = np; gs.K = 1024; es.O = proj; es.ldc = np; es.ss = SSp + (size_t)((2 * l) % 3) * NTOK * 16; dos = true; }
            else if (s == 1) {
                if (l == 1) {
                    for (int t = BID(); t < 6144; t += GDIM()) dil_tile(a, lds, t, proj);
                } else if (l == 2) {
                    for (int rep_ = 0; rep_ < DUP_P; ++rep_) for (int itx = BID(); itx < 2048; itx += GDIM()) ssd_pre(a, lds, itx, proj, mix, cbg, xdtb, acsg);
                } else {
                    const int nitem = l == 0 ? 4096 : 6144;
                    for (int rep_ = 0; rep_ < DUP_PRE; ++rep_) for (int itx = BID(); itx < nitem; itx += GDIM()) { if (l == 0) scan_pre<0>(a, lds, itx, proj, mix, fac, rep_ == DUP_PRE - 1); else scan_pre<3>(a, lds, itx, proj, mix, fac, rep_ == DUP_PRE - 1); }
                }
                if (l == 1) { for (int t = BID(); t < 2048; t += GDIM()) xa_tile(a, lds, l, t, proj, np, xqcol, mix, kout, kout - 256); }
            }
            else if (s == 2) {
                for (int u = BID(); u < 192; u += GDIM()) { if (EN2 & 2) { if (l == 0) scan_seq<0>(a, lds, u, proj, mix, fac); else if (l == 2) ssd_seq(a, lds, u, proj, mix, cbg, xdtb, acsg); else scan_seq<3>(a, lds, u, proj, mix, fac); } }
                unsigned* ctr2 = ctr + 16;
                for (;;) { bar(); if (tid == 0) *bc = atomicAdd(ctr2, 1u); bar(); const unsigned t = *bc; if (t >= 2048u * DUP_XA) break; xa_tile(a, lds, l, (int)t, proj, np, xqcol, mix, kout, kout - 256); }
            }
            else if (s == 3) post_pass(a, l, proj, mix);
            else if (s == 4) { gr.A = mix; gr.Bt = (const bf16_t*)(ws + owout); gr.M = NTOK; gr.N = 1024; gr.K = kout; er.xb = XB; er.fout = nullptr; er.ssn = SSp + (size_t)((2 * l + 1) % 3) * NTOK * 16; dor = true; }
            else if (s == 6 || s == 8) act_pass(a, l, s == 6 ? 0 : 1);
            else {
                if (s == 5 || s == 7) { const int hf = s == 5 ? 0 : 1; gs.A = XB + (size_t)hf * 32768 * 1024; gs.Bt = (const bf16_t*)(ws + O_WUP) + (size_t)l * 5632 * 1024; gs.M = 32768; gs.N = 5632; gs.K = 1024;
                    es.O = (bf16_t*)(ws + O_BIG); es.ldc = 5632; es.ss = SSp + ((size_t)((2 * l + 1) % 3) * NTOK + (size_t)hf * 32768) * 16; dos = true; }
                if (s == 7 || s == 9) { const int hf = s == 7 ? 0 : 1; const size_t ro = (size_t)hf * 32768; gr.A = (const bf16_t*)(ws + O_ACTB); gr.Bt = (const bf16_t*)(ws + O_WDN) + (size_t)l * 1024 * 2816; gr.M = 32768; gr.N = 1024; gr.K = 2816;
                    er.xb = XB + ro * 1024; er.fout = l == 3 ? a->out + ro * 1024 : nullptr; er.ssn = l == 3 ? nullptr : SSp + ((size_t)((2 * l + 2) % 3) * NTOK + ro) * 16; dor = true; }
            }
        }
        if (dor && (EN & 256)) { pg8::StaticOrder S; S.init(gr.M, gr.N, GDIM(), BID()); pg8::gemm_phase<pg8::EpiResid>(lds, gr, S, er); }
        if (ph == 2) { pg8::Gemm g2{}; pg8::EpiScale e2{}; g2.A = (const bf16_t*)(ws + O_MEMN); g2.Bt = (const bf16_t*)(ws + O_WKV); g2.M = 2048; g2.N = 2048; g2.K = 1024; e2.O = (bf16_t*)(ws + O_KVM); e2.ldc = 2048; e2.ss = nullptr;
            pg8::StaticOrder S; S.init(g2.M, g2.N, GDIM(), (BID() + 128) % GDIM()); pg8::gemm_phase<pg8::EpiScale>(lds, g2, S, e2); }
        if (dos && (EN & 512)) { { pg8::StaticOrder S; S.init(gs.M, gs.N, GDIM(), BID()); pg8::gemm_phase<pg8::EpiScale>(lds, gs, S, es); } }
        if (!skip && ph + 1 < ph_hi) { if (ph_hi < 0) cg::this_grid().sync(); xcd_barrier((unsigned*)(a->ws + O_XBAR), (volatile LAS unsigned*)(lds + LDS_BYTES - 32)); }
    }
}

#ifndef NPH_RUN
#endif
#ifndef MK_SINGLE
#define MK_SINGLE 1
#endif
extern "C" void kernel_launch(void* const* d_in, const int* in_sizes, int n_in, void* d_out, int out_size, void* d_ws, size_t ws_size, hipStream_t stream) {
    static int grid = 0;
    if (grid == 0) {
        if (n_in != 34 || ws_size < WS_END) { fprintf(stderr, "kernel_launch: unexpected n_in %d / ws %zu (need %zu)\n", n_in, ws_size, (size_t)WS_END); grid = -1; return; }
        int dev = 0, cus = 0, per_cu = 0;
        (void)hipGetDevice(&dev); (void)hipDeviceGetAttribute(&cus, hipDeviceAttributeMultiprocessorCount, dev);
        (void)hipOccupancyMaxActiveBlocksPerMultiprocessor(&per_cu, (const void*)fwd_kernel, 512, 0);
        (void)hipGetLastError();
        if (per_cu < 1) per_cu = 1;
        grid = cus * per_cu;
    }
    if (grid < 0) return;
#ifdef DIAG_ZERO
    (void)hipMemsetAsync(d_ws, 0, WS_END, stream); (void)hipMemsetAsync(d_out, 0, (size_t)out_size * 4, stream);
#endif
    Args ha{};
    for (int i = 0; i < 34; ++i) ha.in[i] = (const float*)d_in[i];
    ha.out = (float*)d_out; ha.ws = (unsigned char*)d_ws;
#if MK_SINGLE
    (void)hipMemsetAsync((unsigned char*)d_ws + O_XBAR, 0, 16384, stream);
    ha.ph_lo = 0; ha.ph_hi = NPHASE;
    void* args[] = {&ha};
    hipError_t e = hipLaunchCooperativeKernel((const void*)fwd_kernel, dim3(grid), dim3(512), args, 0, stream);
    if (e != hipSuccess) fprintf(stderr, "cooperative launch failed: %s (grid %d)\n", hipGetErrorString(e), grid);
#else
    for (int ph = 0; ph < NPHASE; ++ph) {
        ha.ph_lo = ph; ha.ph_hi = ph + 1;
        hipLaunchKernelGGL(fwd_kernel, dim3(grid), dim3(512), 0, stream, ha);
    }
#endif
}
```
